# Optimizing an MI355X kernel written in HIP

```python
import math
import jax
import jax.numpy as jnp
from jax import lax
import numpy as np

D_MODEL = 1024
BATCH = 8
SEQ = 4096
DEPTH = 2

GRID_W = 64
CTX_LEN = 256
HEAD_DIM = 64
NA_HEADS = 6
NA_WIN_R = 8
NA_WIN_C = 16
NA_QCB = 16
NA_KCB = 32
WG_HEADS = 6
WG_KV_HEADS = 2
WG_WINDOW = 128
WG_BLOCK = 128
SC_CH = 256
SC_GROUPS = 4
CONV_W = 3
D_FF = 2816
ROPE_BASE = 10000.0
EPS = 1e-6
NEG = -1e30

NA_W = NA_HEADS * HEAD_DIM
WG_W = WG_HEADS * HEAD_DIM
WG_KV_W = WG_KV_HEADS * HEAD_DIM
MIX_W = NA_W + WG_W + SC_CH
IN_SPLITS = (NA_W, NA_W, NA_W, WG_W, WG_KV_W, WG_KV_W, SC_CH, SC_CH, SC_CH)
IN_W = sum(IN_SPLITS)

kernel_name = 'hybrid_natten_swa_shortconv_dit_block'


def _rmsnorm(x, g):
    xf = x.astype(jnp.float32)
    y = xf * lax.rsqrt(jnp.mean(xf * xf, axis=-1, keepdims=True) + EPS)
    return (y * g.astype(jnp.float32)).astype(x.dtype)


def _modulate(h, shift, scale):
    return h * (1 + scale) + shift


def _dwconv(x, w):
    L = x.shape[1]
    pad = CONV_W // 2
    xp = jnp.pad(x, ((0, 0), (pad, CONV_W - 1 - pad), (0, 0)))
    out = xp[:, 0:L] * w[0]
    for k in range(1, CONV_W):
        out = out + xp[:, k:k + L] * w[k]
    return out


def _axial_rope(x):
    L = x.shape[1]
    t = jnp.arange(L)
    row = (t // GRID_W).astype(jnp.float32)
    col = (t % GRID_W).astype(jnp.float32)
    half = HEAD_DIM // 2
    n_freq = half // 2
    inv = ROPE_BASE ** (-jnp.arange(n_freq, dtype=jnp.float32) / n_freq)
    ang = jnp.concatenate([row[:, None] * inv, col[:, None] * inv], axis=-1)
    cos = jnp.cos(ang)[None, :, None, :]
    sin = jnp.sin(ang)[None, :, None, :]
    xf = x.astype(jnp.float32)
    x1, x2 = xf[..., :half], xf[..., half:]
    return jnp.concatenate([x1 * cos - x2 * sin, x2 * cos + x1 * sin], axis=-1).astype(x.dtype)


def _ctx_attention(q, k, v, sink=None):
    B, C, Hq, dh = q.shape
    Hkv = k.shape[2]
    G = Hq // Hkv
    qg = q.reshape(B, C, Hkv, G, dh)
    s = jnp.einsum('bqkgd,bckd->bkgqc', qg, k).astype(jnp.float32) * (1.0 / math.sqrt(dh))
    if sink is not None:
        s_sink = jnp.broadcast_to(sink.astype(jnp.float32).reshape(1, Hkv, G, 1, 1), s.shape[:-1] + (1,))
        s = jnp.concatenate([s, s_sink], axis=-1)
    p = jax.nn.softmax(s, axis=-1)[..., :C].astype(v.dtype)
    o = jnp.einsum('bkgqc,bckd->bqkgd', p, v)
    return o.reshape(B, C, Hq * dh)


def _neighbourhood_attention(q, k, v, kc, vc, rpb):
    B, S, H, dh = q.shape
    rows = S // GRID_W
    wr = min(NA_WIN_R, rows)
    ncb = GRID_W // NA_QCB
    nk = wr * NA_KCB
    scale = 1.0 / math.sqrt(dh)
    qg = q.reshape(B, rows, GRID_W, H, dh)
    kg = k.reshape(B, rows, GRID_W, H, dh)
    vg = v.reshape(B, rows, GRID_W, H, dh)
    qcols = np.arange(GRID_W).reshape(ncb, NA_QCB)
    c0 = np.clip(qcols - NA_WIN_C // 2, 0, GRID_W - NA_WIN_C)
    kcols = np.clip(np.arange(ncb) * NA_QCB - NA_WIN_C // 2, 0, GRID_W - NA_KCB)[:, None] + np.arange(NA_KCB)
    col_ok = (kcols[:, None, :] >= c0[:, :, None]) & (kcols[:, None, :] < c0[:, :, None] + NA_WIN_C)
    mask = np.broadcast_to(col_ok[:, :, None, :], (ncb, NA_QCB, wr, NA_KCB)).reshape(ncb, NA_QCB, nk)
    dcol = np.clip(kcols[:, None, :] - qcols[:, :, None] + NA_WIN_C - 1, 0, 2 * NA_WIN_C - 2)

    def row_block(r):
        r0 = jnp.clip(r - wr // 2, 0, rows - wr)
        kr = lax.dynamic_slice_in_dim(kg, r0, wr, axis=1)[:, :, kcols]
        vr = lax.dynamic_slice_in_dim(vg, r0, wr, axis=1)[:, :, kcols]
        kr = jnp.transpose(kr, (0, 2, 1, 3, 4, 5)).reshape(B, ncb, nk, H, dh)
        vr = jnp.transpose(vr, (0, 2, 1, 3, 4, 5)).reshape(B, ncb, nk, H, dh)
        qr = lax.dynamic_index_in_dim(qg, r, axis=1, keepdims=False).reshape(B, ncb, NA_QCB, H, dh)
        drow = r0 + jnp.arange(wr) - r + NA_WIN_R - 1
        bias = rpb[:, drow[None, None, :, None], dcol[:, :, None, :]].reshape(H, ncb, NA_QCB, nk).astype(jnp.float32)
        s_loc = jnp.einsum('bjqhd,bjkhd->bhjqk', qr, kr).astype(jnp.float32) * scale + bias
        s_loc = jnp.where(mask, s_loc, NEG)
        s_ctx = jnp.einsum('bjqhd,bchd->bhjqc', qr, kc).astype(jnp.float32) * scale
        p = jax.nn.softmax(jnp.concatenate([s_loc, s_ctx], axis=-1), axis=-1).astype(v.dtype)
        o = (jnp.einsum('bhjqk,bjkhd->bjqhd', p[..., :nk], vr)
             + jnp.einsum('bhjqc,bchd->bjqhd', p[..., nk:], vc))
        return o.reshape(B, GRID_W, H * dh)

    out = lax.map(row_block, jnp.arange(rows))
    return jnp.transpose(out, (1, 0, 2, 3)).reshape(B, S, H * dh)


def _window_gqa(q, k, v, kc, vc, sink):
    B, S, Hq, dh = q.shape
    Hkv = k.shape[2]
    G = Hq // Hkv
    C = kc.shape[1]
    nb = S // WG_BLOCK
    span = 3 * WG_BLOCK
    scale = 1.0 / math.sqrt(dh)
    qb = q.reshape(B, nb, WG_BLOCK, Hkv, G, dh)
    pad = ((0, 0), (WG_BLOCK, WG_BLOCK), (0, 0), (0, 0))
    kp = jnp.pad(k, pad)
    vp = jnp.pad(v, pad)
    s_sink = jnp.broadcast_to(sink.astype(jnp.float32).reshape(1, Hkv, G, 1, 1), (B, Hkv, G, WG_BLOCK, 1))

    def band_block(i):
        qi = lax.dynamic_index_in_dim(qb, i, axis=1, keepdims=False)
        ki = lax.dynamic_slice_in_dim(kp, i * WG_BLOCK, span, axis=1)
        vi = lax.dynamic_slice_in_dim(vp, i * WG_BLOCK, span, axis=1)
        qpos = i * WG_BLOCK + jnp.arange(WG_BLOCK)
        kpos = (i - 1) * WG_BLOCK + jnp.arange(span)
        ok = (jnp.abs(qpos[:, None] - kpos[None, :]) <= WG_WINDOW) & (kpos >= 0)[None, :] & (kpos < S)[None, :]
        s_loc = jnp.einsum('bqkgd,bnkd->bkgqn', qi, ki).astype(jnp.float32) * scale
        s_loc = jnp.where(ok, s_loc, NEG)
        s_ctx = jnp.einsum('bqkgd,bckd->bkgqc', qi, kc).astype(jnp.float32) * scale
        p = jax.nn.softmax(jnp.concatenate([s_loc, s_ctx, s_sink], axis=-1), axis=-1).astype(v.dtype)
        o = (jnp.einsum('bkgqn,bnkd->bqkgd', p[..., :span], vi)
             + jnp.einsum('bkgqc,bckd->bqkgd', p[..., span:span + C], vc))
        return o.reshape(B, WG_BLOCK, Hq * dh)

    out = lax.map(band_block, jnp.arange(nb))
    return jnp.transpose(out, (1, 0, 2, 3)).reshape(B, S, Hq * dh)


def _mixer_inputs(h, w_in, qn_a, kn_a, qn_b, kn_b):
    B, L, _ = h.shape
    p = h @ w_in
    cuts = [int(i) for i in np.cumsum(IN_SPLITS)[:-1]]
    qa, ka, va, qb, kb, vb, u, bg, cg = jnp.split(p, cuts, axis=-1)
    hd = lambda t: t.reshape(B, L, -1, HEAD_DIM)
    qa = _rmsnorm(hd(qa), qn_a)
    ka = _rmsnorm(hd(ka), kn_a)
    qb = _rmsnorm(hd(qb), qn_b)
    kb = _rmsnorm(hd(kb), kn_b)
    return qa, ka, hd(va), qb, kb, hd(vb), u, bg, cg


def _conv_ffn(h, w_up, conv_ffn, w_down):
    a, g = jnp.split(_dwconv(h @ w_up, conv_ffn), 2, axis=-1)
    return (jax.nn.silu(a) * g) @ w_down


def _layer(xl, xc, mod_l, mod_c, g_attn, w_in, qn_a, kn_a, qn_b, kn_b, rpb_a, sink_b, conv_c, w_o,
           g_ffn, w_up, conv_ffn, w_down, update_ctx):
    sh1, sc1, gt1, sh2, sc2, gt2 = jnp.split(mod_l[:, None, :], 6, axis=-1)
    csh1, csc1, cgt1, csh2, csc2, cgt2 = jnp.split(mod_c, 6, axis=-1)
    hl = _modulate(_rmsnorm(xl, g_attn), sh1, sc1)
    hc = _modulate(_rmsnorm(xc, g_attn), csh1, csc1)
    qa, ka, va, qb, kb, vb, u, bg, cg = _mixer_inputs(hl, w_in, qn_a, kn_a, qn_b, kn_b)
    qa_c, ka_c, va_c, qb_c, kb_c, vb_c, u_c, bg_c, cg_c = _mixer_inputs(hc, w_in, qn_a, kn_a, qn_b, kn_b)
    qb = _axial_rope(qb)
    kb = _axial_rope(kb)
    ya = _neighbourhood_attention(qa, ka, va, ka_c, va_c, rpb_a)
    yb = _window_gqa(qb, kb, vb, kb_c, vb_c, sink_b)
    yc = bg * _dwconv(cg * u, conv_c)
    xl = xl + gt1 * (jnp.concatenate([ya, yb, yc], axis=-1) @ w_o)
    if update_ctx:
        ya_c = _ctx_attention(qa_c, ka_c, va_c)
        yb_c = _ctx_attention(qb_c, kb_c, vb_c, sink_b)
        yc_c = bg_c * _dwconv(cg_c * u_c, conv_c)
        xc = xc + cgt1 * (jnp.concatenate([ya_c, yb_c, yc_c], axis=-1) @ w_o)
    xl = xl + gt2 * _conv_ffn(_modulate(_rmsnorm(xl, g_ffn), sh2, sc2), w_up, conv_ffn, w_down)
    if update_ctx:
        xc = xc + cgt2 * _conv_ffn(_modulate(_rmsnorm(xc, g_ffn), csh2, csc2), w_up, conv_ffn, w_down)
    return xl, xc


def setup_inputs(seed: int = 0) -> dict:
    key = jax.random.key(seed)
    ks = jax.random.split(key, 20)
    nrm = lambda k, shape, s: jax.random.normal(k, shape, jnp.float32) * s
    return {
        'x': nrm(ks[0], (BATCH, SEQ, D_MODEL), 1.0),
        'c': nrm(ks[1], (BATCH, D_MODEL), 1.0),
        'ctx': nrm(ks[2], (BATCH, CTX_LEN, D_MODEL), 1.0),
        'c_ctx': nrm(ks[3], (D_MODEL,), 1.0),
        'w_ada': nrm(ks[4], (DEPTH, D_MODEL, 6 * D_MODEL), 0.5 * D_MODEL ** -0.5),
        'b_ada': nrm(ks[5], (DEPTH, 6 * D_MODEL), 0.02),
        'g_attn': 1.0 + nrm(ks[6], (DEPTH, D_MODEL), 0.01),
        'w_in': nrm(ks[7], (DEPTH, D_MODEL, IN_W), D_MODEL ** -0.5),
        'qn_a': 1.0 + nrm(ks[8], (DEPTH, HEAD_DIM), 0.01),
        'kn_a': 1.0 + nrm(ks[9], (DEPTH, HEAD_DIM), 0.01),
        'qn_b': 1.0 + nrm(ks[10], (DEPTH, HEAD_DIM), 0.01),
        'kn_b': 1.0 + nrm(ks[11], (DEPTH, HEAD_DIM), 0.01),
        'rpb_a': nrm(ks[12], (DEPTH, NA_HEADS, 2 * NA_WIN_R - 1, 2 * NA_WIN_C - 1), 0.1),
        'sink_b': nrm(ks[13], (DEPTH, WG_HEADS), 0.5),
        'conv_c': nrm(ks[14], (DEPTH, CONV_W, SC_CH), CONV_W ** -0.5),
        'w_o': nrm(ks[15], (DEPTH, MIX_W, D_MODEL), MIX_W ** -0.5),
        'g_ffn': 1.0 + nrm(ks[16], (DEPTH, D_MODEL), 0.01),
        'w_up': nrm(ks[17], (DEPTH, D_MODEL, 2 * D_FF), D_MODEL ** -0.5),
        'conv_ffn': nrm(ks[18], (DEPTH, CONV_W, 2 * D_FF), CONV_W ** -0.5),
        'w_down': nrm(ks[19], (DEPTH, D_FF, D_MODEL), D_FF ** -0.5),
    }


def reference(x, c, ctx, c_ctx, w_ada, b_ada, g_attn, w_in, qn_a, kn_a, qn_b, kn_b, rpb_a, sink_b,
              conv_c, w_o, g_ffn, w_up, conv_ffn, w_down):
    xl, xc = x, ctx
    sc = jax.nn.silu(c)
    scc = jax.nn.silu(c_ctx)
    for l in range(DEPTH):
        mod_l = sc @ w_ada[l] + b_ada[l]
        mod_c = scc @ w_ada[l] + b_ada[l]
        xl, xc = _layer(xl, xc, mod_l, mod_c, g_attn[l], w_in[l], qn_a[l], kn_a[l], qn_b[l], kn_b[l],
                        rpb_a[l], sink_b[l], conv_c[l], w_o[l], g_ffn[l], w_up[l], conv_ffn[l], w_down[l],
                        update_ctx=(l < DEPTH - 1))
    return xl
```

```cpp
#include <hip/hip_runtime.h>
#include <hip/hip_cooperative_groups.h>
#include <cstdio>
namespace cg = cooperative_groups;
#define DI __device__ __forceinline__
typedef float f32x16 __attribute__((ext_vector_type(16)));
typedef unsigned u32x2 __attribute__((ext_vector_type(2)));
typedef unsigned u32x4 __attribute__((ext_vector_type(4)));

constexpr int DM = 1024, NBATCH = 8, SEQL = 4096, CTXL = 256;
constexpr int ML = NBATCH * SEQL, MC = NBATCH * CTXL, MT = ML + MC;
constexpr int INW = 2560, DFF = 2816, UPW = 5632, MODW = 6144;
constexpr int QKW = 1280;
constexpr int UBCW = 768;
constexpr int VTR = 512;
constexpr float EPSN = 1e-6f;
constexpr int LDS_BYTES = 131072;

constexpr size_t SZ_WIN = (size_t)INW * DM * 2, SZ_WO = (size_t)DM * DM * 2, SZ_WUP = (size_t)UPW * DM * 2, SZ_WD = (size_t)DM * DFF * 2;
constexpr size_t WS_WIN = 0;
constexpr size_t WS_WO = WS_WIN + 2 * SZ_WIN;
constexpr size_t WS_WUP = WS_WO + 2 * SZ_WO;
constexpr size_t WS_WD = WS_WUP + 2 * SZ_WUP;
constexpr size_t WS_MOD = WS_WD + 2 * SZ_WD;
constexpr size_t WS_ROPE = WS_MOD + (size_t)2 * 9 * MODW * 4;
constexpr size_t WS_NG = WS_ROPE + 8192;
constexpr size_t WS_RC = WS_NG + 2048;
constexpr size_t WS_H = WS_RC + (size_t)MC * DM * 4;
constexpr size_t WS_X = WS_H + (size_t)MT * DM * 2;
constexpr size_t WS_QK = WS_X;
constexpr size_t WS_UBC = WS_QK + (size_t)MT * QKW * 2;
constexpr size_t WS_VT = WS_UBC + (size_t)MT * UBCW * 2;
constexpr size_t WS_Y = WS_VT + (size_t)VTR * MT * 2;
constexpr int CHUNK_ROWS_MAX = 72 * 256;
constexpr size_t WS_UP = WS_X;
constexpr size_t WS_ACT = WS_UP + (size_t)CHUNK_ROWS_MAX * UPW * 2;
constexpr size_t WS_END_A = WS_Y + (size_t)MT * DM * 2, WS_END_B = WS_ACT + (size_t)CHUNK_ROWS_MAX * DFF * 2;
constexpr size_t WS_END = WS_END_A > WS_END_B ? WS_END_A : WS_END_B;

DI unsigned pk2(float lo, float hi) {
    typedef __bf16 bf2 __attribute__((ext_vector_type(2))); typedef float f2 __attribute__((ext_vector_type(2)));
    f2 v = {lo, hi}; bf2 r = __builtin_convertvector(v, bf2); return __builtin_bit_cast(unsigned, r);
}
DI float bflo(unsigned u) { return __uint_as_float(u << 16); }
DI float bfhi(unsigned u) { return __uint_as_float(u & 0xffff0000u); }

namespace pg8 {
#define PG8_LAS __attribute__((address_space(3)))
typedef unsigned short bf16_t;
typedef short bf16x8 __attribute__((ext_vector_type(8)));
typedef float f32x4 __attribute__((ext_vector_type(4)));
typedef unsigned u32x4 __attribute__((ext_vector_type(4)));
constexpr int BM = 256, BK = 64, HALF = 128, HTB = HALF * BK * 2  , STAGE_BYTES = 8 * HTB, NXCD = 8, WGM = 8;

__host__ __device__ __forceinline__ int lds_byte(int r, int c) { const int st = (r >> 4) * 2 + (c >> 5), rr = r & 15, cc = c & 31, ob = rr * 64 + cc * 2; return st * 1024 + (ob ^ (((ob >> 9) & 1) << 5)); }
__host__ __device__ __forceinline__ void stage_rc(int b, int& R, int& C) { const int st = b / 1024, sb = b % 1024, swz = sb ^ (((sb >> 9) & 1) << 5); R = (st >> 1) * 16 + swz / 64; C = (st & 1) * 32 + (swz % 64) / 2; }
__host__ __device__ __forceinline__ int perm32(int rho) { const int n = rho >> 4, i = rho & 15; return 8 * (i >> 2) + 4 * n + (i & 3); }

struct Unit { int pm, pn; };
struct Gemm { const bf16_t* A; const bf16_t* Bt; int M, N, K; };

struct StaticOrder {
    int nM, nN, nwg, G, c;
    __host__ __device__ void init(int M, int N, int G_, int c_) { nM = M / BM; nN = N / BM; nwg = nM * nN; G = G_; c = c_; }
    __host__ __device__ bool next(int i, Unit& u) const {
        const long L = (long)i * G + c; if (L >= nwg) return false;
        int wgid = (int)L; { const int q = nwg / NXCD, r = nwg % NXCD, xcd = wgid % NXCD, off = wgid / NXCD; wgid = (xcd < r ? xcd * (q + 1) : r * (q + 1) + (xcd - r) * q) + off; }
        const int nig = WGM * nN, gid = wgid / nig, fm = gid * WGM, gsz = (nM - fm) < WGM ? (nM - fm) : WGM;
        u.pm = fm + ((wgid % nig) % gsz); u.pn = (wgid % nig) / gsz; return true;
    }
    __device__ __forceinline__ void a_ready(const Unit&) const {}
    __device__ __forceinline__ void done(const Unit&) const {}
};
struct EpiBf16Plain {
    static constexpr bool PERM = true, AFTER_DRAIN = false;
    bf16_t* O; size_t ldc;
    __device__ __forceinline__ void operator()(const f32x4 (&acc)[2][2][4][2], const Unit& u, int wr, int wc, int fr, int fq) const {
        const int row0 = u.pm * BM + wr * 64 + fr, col0 = u.pn * BM + wc * 32 + 8 * fq;
#pragma unroll
        for (int ai = 0; ai < 2; ++ai)
#pragma unroll
            for (int m = 0; m < 4; ++m) { bf16_t* rowp = O + (size_t)(row0 + ai * HALF + m * 16) * ldc + col0;
#pragma unroll
                for (int bj = 0; bj < 2; ++bj) { const f32x4 v0 = acc[ai][bj][m][0], v1 = acc[ai][bj][m][1];
                    u32x4 o; o[0] = pk2(v0[0], v0[1]); o[1] = pk2(v0[2], v0[3]); o[2] = pk2(v1[0], v1[1]); o[3] = pk2(v1[2], v1[3]);
                    *(u32x4*)(rowp + bj * HALF) = o; } }
    }
};
struct EpiResid {
    static constexpr bool PERM = false, AFTER_DRAIN = false;
    const float* src_lat; const float* src_ctx; float* dst_lat; float* dst_ctx; const float* gate; int row0;
    __device__ __forceinline__ void operator()(const f32x4 (&acc)[2][2][4][2], const Unit& u, int wr, int wc, int fr, int fq) const {
        const int rbase = row0 + u.pm * BM; const int b = rbase < ML ? (rbase >> 12) : 8;
        const int col0 = u.pn * BM + wc * 32 + 4 * fq;
        f32x4 gv[2][2];
#pragma unroll
        for (int bj = 0; bj < 2; ++bj)
#pragma unroll
            for (int n = 0; n < 2; ++n) gv[bj][n] = *(const f32x4*)(gate + (size_t)b * MODW + col0 + bj * HALF + n * 16);
#pragma unroll
        for (int ai = 0; ai < 2; ++ai)
#pragma unroll
            for (int m = 0; m < 4; ++m) { const int row = rbase + wr * 64 + fr + ai * HALF + m * 16;
                const float* sp = (row < ML ? src_lat + (size_t)row * DM : src_ctx + (size_t)(row - ML) * DM) + col0;
                float* dp = (row < ML ? dst_lat + (size_t)row * DM : dst_ctx + (size_t)(row - ML) * DM) + col0;
#pragma unroll
                for (int bj = 0; bj < 2; ++bj)
#pragma unroll
                    for (int n = 0; n < 2; ++n) { const f32x4 r4 = *(const f32x4*)(sp + bj * HALF + n * 16);
                        *(f32x4*)(dp + bj * HALF + n * 16) = r4 + gv[bj][n] * acc[ai][bj][m][n]; } }
    }
};
struct EpiInProj {
    static constexpr bool PERM = false, AFTER_DRAIN = false;
    bf16_t* QK; bf16_t* UBC; const float* ng; const float* ropec; const float* ropes;
    __device__ __forceinline__ void operator()(const f32x4 (&acc)[2][2][4][2], const Unit& u, int wr, int wc, int fr, int fq) const {
        const int row0 = u.pm * BM + wr * 64 + fr;
        if (u.pn >= 5) {
            const int col0 = (u.pn - 5) * BM + wc * 32 + 4 * fq;
#pragma unroll
            for (int ai = 0; ai < 2; ++ai)
#pragma unroll
                for (int m = 0; m < 4; ++m) { bf16_t* rowp = UBC + (size_t)(row0 + ai * HALF + m * 16) * UBCW + col0;
#pragma unroll
                    for (int bj = 0; bj < 2; ++bj)
#pragma unroll
                        for (int n = 0; n < 2; ++n) { const f32x4 v = acc[ai][bj][m][n]; u32x2 o; o[0] = pk2(v[0], v[1]); o[1] = pk2(v[2], v[3]);
                            *(u32x2*)(rowp + bj * HALF + n * 16) = o; } }
            return;
        }
        const int Hh = 4 * u.pn + wc;
        const float* g = ng + 64 * (Hh < 6 ? 0 : (Hh < 12 ? 1 : (Hh < 18 ? 2 : 3)));
        const float qs = (Hh < 6 || (Hh >= 12 && Hh < 18)) ? 0.125f : 1.0f;
        const bool rope = Hh >= 12;
        f32x4 gv[2][2];
#pragma unroll
        for (int bj = 0; bj < 2; ++bj)
#pragma unroll
            for (int n = 0; n < 2; ++n) gv[bj][n] = *(const f32x4*)(g + bj * 32 + n * 16 + 4 * fq) * qs;
#pragma unroll
        for (int ai = 0; ai < 2; ++ai)
#pragma unroll
            for (int m = 0; m < 4; ++m) {
                const int row = row0 + ai * HALF + m * 16;
                float ss = 0.f;
#pragma unroll
                for (int bj = 0; bj < 2; ++bj)
#pragma unroll
                    for (int n = 0; n < 2; ++n) { const f32x4 v = acc[ai][bj][m][n]; ss += v[0] * v[0] + v[1] * v[1] + v[2] * v[2] + v[3] * v[3]; }
                ss += __shfl_xor(ss, 16); ss += __shfl_xor(ss, 32);
                const float rstd = rsqrtf(ss * (1.0f / 64.0f) + EPSN);
                f32x4 y[2][2];
#pragma unroll
                for (int bj = 0; bj < 2; ++bj)
#pragma unroll
                    for (int n = 0; n < 2; ++n) y[bj][n] = acc[ai][bj][m][n] * rstd * gv[bj][n];
                if (rope && row < ML) {
                    const int t = row & (SEQL - 1); const int gr = t >> 6, gc = t & 63;
#pragma unroll
                    for (int n = 0; n < 2; ++n) { const int pos = n == 0 ? gr : gc;
                        const f32x4 c4 = *(const f32x4*)(ropec + pos * 16 + 4 * fq), s4 = *(const f32x4*)(ropes + pos * 16 + 4 * fq);
                        const f32x4 x1 = y[0][n], x2 = y[1][n];
                        y[0][n] = x1 * c4 - x2 * s4; y[1][n] = x2 * c4 + x1 * s4; }
                }
                bf16_t* rowp = QK + ((size_t)row * 20 + Hh) * 64 + 4 * fq;
#pragma unroll
                for (int bj = 0; bj < 2; ++bj)
#pragma unroll
                    for (int n = 0; n < 2; ++n) { const f32x4 v = y[bj][n]; u32x2 o; o[0] = pk2(v[0], v[1]); o[1] = pk2(v[2], v[3]);
                        *(u32x2*)(rowp + bj * 32 + n * 16) = o; }
            }
    }
};
template <class Epi, class Sched, bool STAMP = false>
__device__ __forceinline__ void gemm_phase(PG8_LAS unsigned char* lds, const Gemm g, const Sched& S, const Epi& E, unsigned long long* stamps) {
    int tid_ = threadIdx.x; asm volatile("" : "+v"(tid_)); const int tid = tid_, wid = __builtin_amdgcn_readfirstlane(tid >> 6), lane = tid & 63, wr = wid >> 2, wc = wid & 3, fr = lane & 15, fq = lane >> 4;
    const int K = g.K, nt = K / BK;
    int ts_lo = 0, ts_hi = 0, nts = 0; const unsigned long long rt_entry = STAMP ? (unsigned long long)wall_clock64() : 0ull;
#define PG8_STAMP() do { if (STAMP && wid == 0 && nts < 64) { const unsigned long long _c = (unsigned long long)clock64(); \
        ts_lo = (lane == nts) ? (int)(unsigned)_c : ts_lo; ts_hi = (lane == nts) ? (int)(unsigned)(_c >> 32) : ts_hi; ++nts; } } while (0)
    PG8_STAMP();
    unsigned voffA[2], voffB[2];
#pragma unroll
    for (int i = 0; i < 2; ++i) { int R, C; stage_rc(tid * 16 + i * 8192, R, C); const int Rb = Epi::PERM ? ((R & ~31) + perm32(R & 31)) : R;
        voffA[i] = (unsigned)(R * K + C) * 2u; voffB[i] = (unsigned)(Rb * K + C) * 2u; }
    const size_t kstep = (size_t)(BK * 2);
    const size_t hstep = (size_t)HALF * K * 2;
    const size_t tstep = 2 * hstep;
    const unsigned ldsw = (unsigned)wid * 1024u;
    const int aoff = lds_byte(wr * 64 + fr, fq * 8), boff = lds_byte(wc * 32 + fr, fq * 8);
#define PG8_SA(b, h) (((b) * 2 + (h)) * HTB)
#define PG8_SB(b, h) ((4 + (b) * 2 + (h)) * HTB)
#define PG8_STAGE(bufoff, gbase, voff) do { _Pragma("unroll") for (int _i = 0; _i < 2; ++_i) \
        __builtin_amdgcn_global_load_lds((const unsigned*)((const char*)(gbase) + (voff)[_i]), (PG8_LAS unsigned*)(lds + (bufoff) + ldsw + _i * 8192), 16, 0, 0); } while (0)
#define PG8_LDA(dst, b, h) do { _Pragma("unroll") for (int m = 0; m < 4; ++m) _Pragma("unroll") for (int k = 0; k < 2; ++k) dst[m][k] = *(const PG8_LAS bf16x8*)(lds + PG8_SA(b, h) + aoff + m * 2048 + k * 1024); } while (0)
#define PG8_LDB(dst, b, h) do { _Pragma("unroll") for (int n = 0; n < 2; ++n) _Pragma("unroll") for (int k = 0; k < 2; ++k) dst[n][k] = *(const PG8_LAS bf16x8*)(lds + PG8_SB(b, h) + boff + n * 2048 + k * 1024); } while (0)
#define PG8_MMA(ai, bj, At, Bt) do { __builtin_amdgcn_s_setprio(1); _Pragma("unroll") for (int m = 0; m < 4; ++m) _Pragma("unroll") for (int n = 0; n < 2; ++n) _Pragma("unroll") for (int k = 0; k < 2; ++k) \
        acc[ai][bj][m][n] = __builtin_amdgcn_mfma_f32_16x16x32_bf16(Bt[n][k], At[m][k], acc[ai][bj][m][n], 0, 0, 0); __builtin_amdgcn_s_setprio(0); } while (0)
#define PG8_WAIT_V(n) asm volatile("s_waitcnt vmcnt(" #n ")" ::: "memory")
#define PG8_WAIT_L(n) asm volatile("s_waitcnt lgkmcnt(" #n ")" ::: "memory")
#define PG8_BAR __builtin_amdgcn_s_barrier()
#define PG8_SCHED __builtin_amdgcn_sched_barrier(0)
    Unit cur, nxt; int ui = 0;
    if (!S.next(0, cur)) return;
    f32x4 acc[2][2][4][2];
#pragma unroll
    for (int a = 0; a < 2; ++a)
#pragma unroll
        for (int b = 0; b < 2; ++b)
#pragma unroll
            for (int m = 0; m < 4; ++m)
#pragma unroll
                for (int n = 0; n < 2; ++n) acc[a][b][m][n] = (f32x4){0.f, 0.f, 0.f, 0.f};
    bf16x8 At[4][2], B0[2][2], B1[2][2];
    const char* cA = (const char*)g.A + (size_t)cur.pm * tstep; const char* cB = (const char*)g.Bt + (size_t)cur.pn * tstep;
    S.a_ready(cur);
    PG8_STAGE(PG8_SB(0, 0), cB, voffB); PG8_STAGE(PG8_SA(0, 0), cA, voffA); PG8_STAGE(PG8_SB(0, 1), cB + hstep, voffB); PG8_STAGE(PG8_SA(0, 1), cA + hstep, voffA);
    if (wr == 1) PG8_BAR;
    PG8_WAIT_V(4); PG8_BAR;
    PG8_STAGE(PG8_SB(1, 0), cB + kstep, voffB); PG8_STAGE(PG8_SA(1, 0), cA + kstep, voffA); PG8_STAGE(PG8_SB(1, 1), cB + hstep + kstep, voffB);
    PG8_WAIT_V(6); PG8_BAR;
    PG8_STAMP();
    for (;;) {
        const bool has_next = S.next(ui + 1, nxt);
        const char* nA = has_next ? (const char*)g.A + (size_t)nxt.pm * tstep : cA; const char* nB = has_next ? (const char*)g.Bt + (size_t)nxt.pn * tstep : cB;
        for (int t = 0; t < nt; t += 2) {
            const bool last = (t == nt - 2);
            const char* a1 = cA + (size_t)(t + 1) * kstep;
            const char* a2 = last ? nA : cA + (size_t)(t + 2) * kstep; const char* b2 = last ? nB : cB + (size_t)(t + 2) * kstep;
            const char* a3 = a2 + kstep; const char* b3 = b2 + kstep;
            if (last && has_next) S.a_ready(nxt);
            PG8_LDB(B0, 0, 0); PG8_SCHED; PG8_LDA(At, 0, 0); PG8_STAGE(PG8_SA(1, 1), a1 + hstep, voffA);
            PG8_WAIT_L(8); PG8_BAR; PG8_WAIT_L(0); PG8_MMA(0, 0, At, B0); PG8_BAR; PG8_SCHED;
            PG8_LDB(B1, 0, 1); PG8_STAGE(PG8_SB(0, 0), b2, voffB);
            PG8_BAR; PG8_WAIT_L(0); PG8_MMA(0, 1, At, B1); PG8_BAR;
            PG8_LDA(At, 0, 1); PG8_STAGE(PG8_SA(0, 0), a2, voffA);
            PG8_BAR; PG8_WAIT_L(0); PG8_MMA(1, 0, At, B0); PG8_BAR; PG8_SCHED;
            PG8_STAGE(PG8_SB(0, 1), b2 + hstep, voffB);
            PG8_WAIT_V(6); PG8_BAR; PG8_MMA(1, 1, At, B1); PG8_BAR;
            PG8_LDB(B0, 1, 0); PG8_SCHED; PG8_LDA(At, 1, 0); PG8_STAGE(PG8_SA(0, 1), a2 + hstep, voffA);
            PG8_WAIT_L(8); PG8_BAR; PG8_WAIT_L(0); PG8_MMA(0, 0, At, B0); PG8_BAR; PG8_SCHED;
            PG8_LDB(B1, 1, 1); PG8_STAGE(PG8_SB(1, 0), b3, voffB);
            PG8_BAR; PG8_WAIT_L(0); PG8_MMA(0, 1, At, B1); PG8_BAR;
            PG8_LDA(At, 1, 1); PG8_STAGE(PG8_SA(1, 0), a3, voffA);
            PG8_BAR; PG8_WAIT_L(0); PG8_MMA(1, 0, At, B0); PG8_BAR; PG8_SCHED;
            PG8_STAGE(PG8_SB(1, 1), b3 + hstep, voffB);
            PG8_WAIT_V(6); PG8_BAR; PG8_MMA(1, 1, At, B1); PG8_BAR;
        }
        PG8_STAMP();
        if constexpr (!Epi::AFTER_DRAIN) { E(acc, cur, wr, wc, fr, fq); S.done(cur); }
        PG8_STAMP();
        if (!has_next) break;
#pragma unroll
        for (int a = 0; a < 2; ++a)
#pragma unroll
            for (int b = 0; b < 2; ++b)
#pragma unroll
                for (int m = 0; m < 4; ++m)
#pragma unroll
                    for (int n = 0; n < 2; ++n) acc[a][b][m][n] = (f32x4){0.f, 0.f, 0.f, 0.f};
        cur = nxt; cA = nA; cB = nB; ++ui;
    }
    PG8_WAIT_V(0);
    if (wr == 0) PG8_BAR;
    PG8_BAR;
    if constexpr (Epi::AFTER_DRAIN) { E.fused(acc, cur, wr, wc, fr, fq, lds, wid, lane); S.done(cur); }
    PG8_STAMP();
    if (STAMP && wid == 0) { stamps[lane] = lane < nts ? (((unsigned long long)(unsigned)ts_hi << 32) | (unsigned)ts_lo) : 0ull;
        if (lane == 62) stamps[62] = rt_entry; if (lane == 63) stamps[63] = (unsigned long long)wall_clock64(); }
#undef PG8_STAMP
#undef PG8_SA
#undef PG8_SB
#undef PG8_STAGE
#undef PG8_LDA
#undef PG8_LDB
#undef PG8_MMA
#undef PG8_WAIT_V
#undef PG8_WAIT_L
#undef PG8_BAR
#undef PG8_SCHED
}
}
using pg8::f32x4; using pg8::bf16_t; using pg8::bf16x8;

struct Params { const float* in[20]; float* out; unsigned char* ws; int ph_lo, ph_hi; };
enum { I_X = 0, I_C, I_CTX, I_CCTX, I_WADA, I_BADA, I_GATTN, I_WIN, I_QNA, I_KNA, I_QNB, I_KNB, I_RPB, I_SINK, I_CONVC, I_WO, I_GFFN, I_WUP, I_CONVF, I_WDOWN };

DI int ltid() { int t = threadIdx.x; asm volatile("" : "+v"(t)); return t; }
DI float wave_sum(float v) {
#pragma unroll
    for (int o = 32; o >= 1; o >>= 1) v += __shfl_xor(v, o);
    return v;
}

DI int win_src_col(int n) {
    if (n < 1280) { const int pn = n >> 8, cs = n & 255, bj = cs >> 7, wc = (cs & 127) >> 5, w = cs & 31, Hh = 4 * pn + wc;
        const int hc = Hh < 6 ? 64 * Hh : (Hh < 12 ? 384 + 64 * (Hh - 6) : (Hh < 18 ? 1152 + 64 * (Hh - 12) : 1536 + 64 * (Hh - 18)));
        return hc + 32 * bj + w; }
    if (n < 2048) return 1792 + (n - 1280);
    const int v = n - 2048; return v < 384 ? 768 + v : 1664 + (v - 384);
}
DI void phase_prep(const Params& p, float* sm) {
    const int tid = ltid(); unsigned char* ws = p.ws;
    if (blockIdx.x == 0) {
        float* rc = (float*)(ws + WS_ROPE); float* rs = rc + 1024;
        for (int e = tid; e < 1024; e += 512) { const int pos = e >> 4, f = e & 15;
            float invf = 1.0f;
#define IV(i, v) invf = (f == (i)) ? (v) : invf
            IV(1, 0.5623413324356079f); IV(2, 0.3162277638912201f); IV(3, 0.17782793939113617f); IV(4, 0.10000000149011612f); IV(5, 0.05623413249850273f); IV(6, 0.03162277489900589f); IV(7, 0.017782794311642647f);
            IV(8, 0.009999999776482582f); IV(9, 0.005623413249850273f); IV(10, 0.003162277629598975f); IV(11, 0.0017782794311642647f); IV(12, 0.0010000000474974513f); IV(13, 0.000562341301701963f); IV(14, 0.0003162277571391314f); IV(15, 0.00017782794020604342f);
#undef IV
            const float ang = (float)pos * invf; const double x = (double)ang;
            const double n = rint(x * 0.15915494309189535); const double r = x - n * 6.283185307179586476925; const double r2 = r * r;
            double c = 1.0, s = r, tc = 1.0, tsn = r;
#pragma unroll 1
            for (int i = 1; i <= 15; ++i) { tc *= -r2 / (double)((2 * i - 1) * (2 * i)); c += tc; tsn *= -r2 / (double)((2 * i) * (2 * i + 1)); s += tsn; }
            rc[e] = (float)c; rs[e] = (float)s; }
        { float* ng = (float*)(ws + WS_NG); const int l = tid >> 8, w = (tid >> 6) & 3, d = tid & 63;
          const float* s0 = w == 0 ? p.in[I_QNA] : (w == 1 ? p.in[I_KNA] : (w == 2 ? p.in[I_QNB] : p.in[I_KNB])); ng[tid] = s0[l * 64 + d]; }
    }
    {
        float* scv = sm; float* red = sm + 9 * 1024;
        bool loaded = false;
        for (int it = blockIdx.x; it < 192; it += gridDim.x) {
            if (!loaded) { for (int i = tid; i < 9 * 1024; i += 512) { const float v = i < 8192 ? p.in[I_C][i] : p.in[I_CCTX][i - 8192]; scv[i] = v / (1.0f + __expf(-v)); } loaded = true; __syncthreads(); }
            const int l = it / 96, j0 = (it % 96) * 64, tx = tid & 15, ty = tid >> 4;
            f32x4 a[9];
#pragma unroll
            for (int b = 0; b < 9; ++b) a[b] = (f32x4){0.f, 0.f, 0.f, 0.f};
            const float* wp = p.in[I_WADA] + (size_t)l * DM * MODW + j0 + 4 * tx;
#pragma unroll 4
            for (int i = 0; i < 32; ++i) { const int k = ty + 32 * i; const f32x4 w4 = *(const f32x4*)(wp + (size_t)k * MODW);
#pragma unroll
                for (int b = 0; b < 9; ++b) a[b] += w4 * scv[b * 1024 + k]; }
#pragma unroll
            for (int b = 0; b < 9; ++b) *(f32x4*)(red + (ty * 9 + b) * 64 + 4 * tx) = a[b];
            __syncthreads();
            for (int o = tid; o < 576; o += 512) { const int b = o >> 6, ci = o & 63; float s = 0.f;
                for (int y = 0; y < 32; ++y) s += red[(y * 9 + b) * 64 + ci];
                ((float*)(ws + WS_MOD))[(size_t)(l * 9 + b) * MODW + j0 + ci] = s + p.in[I_BADA][l * MODW + j0 + ci]; }
            __syncthreads();
        }
        __syncthreads();
    }
    for (int t = blockIdx.x; t < 6016; t += gridDim.x) {
        const int l = t / 3008; int r = t % 3008; int which, tn, tk, K, srcN;
        if (r < 640) { which = 0; tn = r >> 4; tk = r & 15; K = 1024; srcN = INW; }
        else if (r < 896) { r -= 640; which = 1; tn = r >> 4; tk = r & 15; K = 1024; srcN = DM; }
        else if (r < 2304) { r -= 896; which = 2; tn = r >> 4; tk = r & 15; K = 1024; srcN = UPW; }
        else { r -= 2304; which = 3; tn = r / 44; tk = r % 44; K = DFF; srcN = DM; }
        const float* src = which == 0 ? p.in[I_WIN] + (size_t)l * DM * INW : (which == 1 ? p.in[I_WO] + (size_t)l * DM * DM : (which == 2 ? p.in[I_WUP] + (size_t)l * DM * UPW : p.in[I_WDOWN] + (size_t)l * DFF * DM));
        bf16_t* dst = (bf16_t*)(ws + (which == 0 ? WS_WIN + l * SZ_WIN : (which == 1 ? WS_WO + l * SZ_WO : (which == 2 ? WS_WUP + l * SZ_WUP : WS_WD + l * SZ_WD))));
        const int n0 = tn * 64, k0 = tk * 64;
        { const int nl = tid & 63, kb = tid >> 6; const int sc = which == 0 ? win_src_col(n0 + nl) : n0 + nl;
#pragma unroll
          for (int i = 0; i < 8; ++i) { const int k = kb + 8 * i; sm[k * 65 + nl] = src[(size_t)(k0 + k) * srcN + sc]; } }
        __syncthreads();
        { const int n = tid >> 3, kg = tid & 7; float v[8];
#pragma unroll
          for (int j = 0; j < 8; ++j) v[j] = sm[(8 * kg + j) * 65 + n];
          u32x4 o; o[0] = pk2(v[0], v[1]); o[1] = pk2(v[2], v[3]); o[2] = pk2(v[4], v[5]); o[3] = pk2(v[6], v[7]);
          *(u32x4*)(dst + (size_t)(n0 + n) * K + k0 + 8 * kg) = o; }
        __syncthreads();
    }
}

DI void phase_prenorm(const float* lat, const float* ctxp, const float* g, const float* modl, int shoff, int scoff, bf16_t* H, int nrows) {
    const int tid = ltid(); const int lane = tid & 63, gw = blockIdx.x * 8 + (tid >> 6), nw = gridDim.x * 8;
    f32x4 g4[4];
#pragma unroll
    for (int i = 0; i < 4; ++i) g4[i] = *(const f32x4*)(g + 256 * i + 4 * lane);
    for (int row = gw; row < nrows; row += nw) {
        const float* src = row < ML ? lat + (size_t)row * DM : ctxp + (size_t)(row - ML) * DM; const int b = row < ML ? (row >> 12) : 8;
        f32x4 v[4]; float ss = 0.f;
#pragma unroll
        for (int i = 0; i < 4; ++i) { v[i] = *(const f32x4*)(src + 256 * i + 4 * lane); ss += v[i][0] * v[i][0] + v[i][1] * v[i][1] + v[i][2] * v[i][2] + v[i][3] * v[i][3]; }
        ss = wave_sum(ss); const float rstd = rsqrtf(ss * (1.0f / 1024.0f) + EPSN);
        const float* mb = modl + (size_t)b * MODW;
#pragma unroll
        for (int i = 0; i < 4; ++i) { const int col = 256 * i + 4 * lane; const f32x4 sc4 = *(const f32x4*)(mb + scoff + col), sh4 = *(const f32x4*)(mb + shoff + col);
            const f32x4 y = v[i] * rstd * g4[i] * (sc4 + 1.0f) + sh4; u32x2 o; o[0] = pk2(y[0], y[1]); o[1] = pk2(y[2], y[3]);
            *(u32x2*)(H + (size_t)row * DM + col) = o; }
    }
}

DI void unpack8(const u32x4 u, float (&f)[8]) {
#pragma unroll
    for (int i = 0; i < 4; ++i) { f[2 * i] = bflo(u[i]); f[2 * i + 1] = bfhi(u[i]); }
}
DI void phase_convact(const bf16_t* UP, bf16_t* ACT, const float* cw  , int row0, int nrows) {
    const long total = (long)nrows * 352; const long stride = (long)gridDim.x * 512;
    const int tid = ltid();
    for (long i = (long)blockIdx.x * 512 + tid; i < total; i += stride) {
        const int rl = (int)(i / 352), cg8 = (int)(i % 352), c = cg8 * 8; const int row = row0 + rl;
        int t, L; if (row < ML) { t = row & (SEQL - 1); L = SEQL; } else { t = (row - ML) & (CTXL - 1); L = CTXL; }
        const bool hp = t > 0, hn = t < L - 1;
        float a[8], g[8];
#pragma unroll
        for (int j = 0; j < 8; ++j) { a[j] = 0.f; g[j] = 0.f; }
#pragma unroll
        for (int k = 0; k < 3; ++k) {
            if ((k == 0 && !hp) || (k == 2 && !hn)) continue;
            const bf16_t* up = UP + (size_t)(rl + k - 1) * UPW + c;
            float ua[8], ug[8]; unpack8(*(const u32x4*)up, ua); unpack8(*(const u32x4*)(up + DFF), ug);
            const f32x4 wa0 = *(const f32x4*)(cw + k * UPW + c), wa1 = *(const f32x4*)(cw + k * UPW + c + 4), wg0 = *(const f32x4*)(cw + k * UPW + DFF + c), wg1 = *(const f32x4*)(cw + k * UPW + DFF + c + 4);
#pragma unroll
            for (int j = 0; j < 4; ++j) { a[j] += ua[j] * wa0[j]; a[4 + j] += ua[4 + j] * wa1[j]; g[j] += ug[j] * wg0[j]; g[4 + j] += ug[4 + j] * wg1[j]; }
        }
        float o[8];
#pragma unroll
        for (int j = 0; j < 8; ++j) o[j] = a[j] / (1.0f + __expf(-a[j])) * g[j];
        u32x4 ov; ov[0] = pk2(o[0], o[1]); ov[1] = pk2(o[2], o[3]); ov[2] = pk2(o[4], o[5]); ov[3] = pk2(o[6], o[7]);
        *(u32x4*)(ACT + (size_t)rl * DFF + c) = ov;
    }
}

#define MFMA32(a, b, c) __builtin_amdgcn_mfma_f32_32x32x16_bf16((a), (b), (c), 0, 0, 0)
constexpr int RPB_PITCH = 80, RPB_SHIFT = 24;
struct AttnAcc { f32x16 o0, o1; float m, l; };
struct MBNone { DI float operator()(int, float s) const { return s; } };
template <int REM> struct MBNa {
    const float* bl; int v0;
    DI float operator()(int r, float s) const {
        const int off = REM ? (r & 7) : 16 * (r >> 3) + (r & 7);
        const float bias = bl[REM ? (2 * (r >> 3)) * RPB_PITCH + (r & 7) : off];
        return ((unsigned)(off - v0) < 16u) ? s + bias : -1e30f;
    }
};
template <int LAST> struct MBWg {
    int qh;
    DI float operator()(int r, float s) const { const int d = 16 * (r >> 3) + (r & 7) - qh; return (LAST ? d <= 0 : d >= 0) ? s : -1e30f; }
};
template <class MB> DI void attn_tile(AttnAcc& a, const bf16x8 (&qf)[4], const bf16_t* kp, const bf16_t* vA, const bf16_t* vB, const MB& mb) {
    bf16x8 kf[4];
#pragma unroll
    for (int kk = 0; kk < 4; ++kk) kf[kk] = *(const bf16x8*)(kp + 16 * kk);
    const bf16x8 v00 = *(const bf16x8*)vA, v01 = *(const bf16x8*)vB, v10 = *(const bf16x8*)(vA + (size_t)32 * MT), v11 = *(const bf16x8*)(vB + (size_t)32 * MT);
    f32x16 s;
#pragma unroll
    for (int r = 0; r < 16; ++r) s[r] = 0.f;
#pragma unroll
    for (int kk = 0; kk < 4; ++kk) s = MFMA32(kf[kk], qf[kk], s);
    float tmax = -1e30f;
#pragma unroll
    for (int r = 0; r < 16; ++r) { s[r] = mb(r, s[r]); tmax = fmaxf(tmax, s[r]); }
    tmax = fmaxf(tmax, __shfl_xor(tmax, 32));
    const float mn = fmaxf(a.m, tmax); const float alpha = __expf(a.m - mn); a.m = mn;
    float ls = 0.f;
#pragma unroll
    for (int r = 0; r < 16; ++r) { const float pv = __expf(s[r] - mn); ls += pv; s[r] = pv; }
    a.l = a.l * alpha + ls;
#pragma unroll
    for (int r = 0; r < 16; ++r) { a.o0[r] *= alpha; a.o1[r] *= alpha; }
    u32x4 p0, p1;
#pragma unroll
    for (int j = 0; j < 4; ++j) { p0[j] = pk2(s[2 * j], s[2 * j + 1]); p1[j] = pk2(s[8 + 2 * j], s[8 + 2 * j + 1]); }
    const bf16x8 pb0 = __builtin_bit_cast(bf16x8, p0), pb1 = __builtin_bit_cast(bf16x8, p1);
    a.o0 = MFMA32(v00, pb0, a.o0); a.o0 = MFMA32(v01, pb1, a.o0);
    a.o1 = MFMA32(v10, pb0, a.o1); a.o1 = MFMA32(v11, pb1, a.o1);
}

DI void attn_item(int lane, int type, int idx, const bf16_t* QK, const bf16_t* VT, bf16_t* Y, const float* tab, const float* sink) {
    const int q = lane & 31, h = lane >> 5;
    const int pi = 16 * (q >> 4) + 8 * ((q >> 2) & 1) + 4 * ((q >> 3) & 1) + (q & 3);
    int head, b, qrow, Hq, Hk, vrow0, ocol; bool has_sink;
    int jj = 0, rq = 0, t0 = 0;
    if (type == 0) { head = idx % 6; int t = idx / 6; jj = t & 1; t >>= 1; rq = t & 63; b = t >> 6; qrow = b * SEQL + rq * 64 + 32 * jj + q; Hq = head; Hk = 6 + head; vrow0 = 64 * head; ocol = 64 * head; has_sink = false; }
    else if (type == 1) { head = idx % 6; int t = idx / 6; const int qb = t & 127; b = t >> 7; t0 = qb * 32; qrow = b * SEQL + t0 + q; Hq = 12 + head; Hk = 18 + head / 3; vrow0 = 384 + 64 * (head / 3); ocol = 384 + 64 * head; has_sink = true; }
    else { head = idx % 6; int t = idx / 6; const int qb = t & 7; b = t >> 3; qrow = ML + b * CTXL + qb * 32 + q;
        if (type == 2) { Hq = head; Hk = 6 + head; vrow0 = 64 * head; ocol = 64 * head; has_sink = false; }
        else { Hq = 12 + head; Hk = 18 + head / 3; vrow0 = 384 + 64 * (head / 3); ocol = 384 + 64 * head; has_sink = true; } }
    bf16x8 qf[4];
    { const bf16_t* qp = QK + ((size_t)qrow * 20 + Hq) * 64 + 8 * h;
#pragma unroll
      for (int kk = 0; kk < 4; ++kk) qf[kk] = *(const bf16x8*)(qp + 16 * kk); }
    AttnAcc a;
#pragma unroll
    for (int r = 0; r < 16; ++r) { a.o0[r] = 0.f; a.o1[r] = 0.f; }
    if (has_sink) { a.m = sink[head]; a.l = h == 0 ? 1.0f : 0.0f; } else { a.m = -1e30f; a.l = 0.f; }
    const bf16_t* Kh = QK + (size_t)Hk * 64 + 8 * h;
    const bf16_t* Vd = VT + (size_t)(vrow0 + q) * MT;
    { const int cb = ML + b * CTXL;
#pragma unroll 1
      for (int c = 0; c < 8; ++c) { const int tb = cb + 32 * c;
          attn_tile(a, qf, Kh + (size_t)(tb + pi) * QKW, Vd + tb + 8 * h, Vd + tb + 16 + 8 * h, MBNone{}); } }
    if (type == 0) {
        const int cq = 32 * jj + q; const int r0 = min(max(rq - 4, 0), 56), c0 = min(max(cq - 8, 0), 48);
        const float* th = tab + (size_t)head * 15 * RPB_PITCH + RPB_SHIFT;
#pragma unroll 1
        for (int i = 0; i < 8; ++i) { const int tb = b * SEQL + (r0 + i) * 64 + 24 * jj; const int drow = r0 + i - rq + 7;
            MBNa<0> mb{th + drow * RPB_PITCH + (8 * h + 15 - 8 * jj - q), c0 - 24 * jj - 8 * h};
            attn_tile(a, qf, Kh + (size_t)(tb + pi) * QKW, Vd + tb + 8 * h, Vd + tb + 16 + 8 * h, mb); }
#pragma unroll 1
        for (int tbk = 0; tbk < 2; ++tbk) { const int rb = b * SEQL + (r0 + 4 * tbk) * 64 + 24 * jj + 32;
            MBNa<1> mb{th + (r0 + 4 * tbk - rq + 7 + h) * RPB_PITCH + (47 - 8 * jj - q), c0 - 24 * jj - 32};
            attn_tile(a, qf, Kh + (size_t)(rb + (pi >> 3) * 64 + (pi & 7)) * QKW, Vd + rb + h * 64, Vd + rb + (2 + h) * 64, mb); }
    } else if (type == 1) {
#pragma unroll 1
        for (int m = 0; m < 9; ++m) { const int ks = t0 - 128 + 32 * m; if (ks < 0 || ks >= SEQL) continue; const int tb = b * SEQL + ks;
            const bf16_t* kp = Kh + (size_t)(tb + pi) * QKW; const bf16_t* vA = Vd + tb + 8 * h; const bf16_t* vB = vA + 16;
            if (m == 0) attn_tile(a, qf, kp, vA, vB, MBWg<0>{q - 8 * h});
            else if (m == 8) attn_tile(a, qf, kp, vA, vB, MBWg<1>{q - 8 * h});
            else attn_tile(a, qf, kp, vA, vB, MBNone{}); }
    }
    const float lt = a.l + __shfl_xor(a.l, 32); const float inv = 1.0f / lt;
    bf16_t* yp = Y + (size_t)qrow * DM + ocol + 4 * h;
#pragma unroll
    for (int g = 0; g < 4; ++g) { u32x2 o0, o1;
        o0[0] = pk2(a.o0[4 * g] * inv, a.o0[4 * g + 1] * inv); o0[1] = pk2(a.o0[4 * g + 2] * inv, a.o0[4 * g + 3] * inv);
        o1[0] = pk2(a.o1[4 * g] * inv, a.o1[4 * g + 1] * inv); o1[1] = pk2(a.o1[4 * g + 2] * inv, a.o1[4 * g + 3] * inv);
        *(u32x2*)(yp + 8 * g) = o0; *(u32x2*)(yp + 32 + 8 * g) = o1; }
}
DI void sconv_item(int lane, int item, const bf16_t* UBC, bf16_t* Y, const float* cw  ) {
    const int c = (lane & 31) * 8;
    f32x4 w[3][2];
#pragma unroll
    for (int k = 0; k < 3; ++k) { w[k][0] = *(const f32x4*)(cw + k * 256 + c); w[k][1] = *(const f32x4*)(cw + k * 256 + c + 4); }
#pragma unroll 1
    for (int it = 0; it < 32; ++it) {
        const int row = item * 64 + it * 2 + (lane >> 5);
        int t, L; if (row < ML) { t = row & (SEQL - 1); L = SEQL; } else { t = (row - ML) & (CTXL - 1); L = CTXL; }
        float acc[8];
#pragma unroll
        for (int j = 0; j < 8; ++j) acc[j] = 0.f;
#pragma unroll
        for (int k = 0; k < 3; ++k) {
            if ((k == 0 && t == 0) || (k == 2 && t == L - 1)) continue;
            const bf16_t* rp = UBC + (size_t)(row + k - 1) * UBCW + c; float u[8], cgv[8]; unpack8(*(const u32x4*)rp, u); unpack8(*(const u32x4*)(rp + 512), cgv);
#pragma unroll
            for (int j = 0; j < 8; ++j) acc[j] += (cgv[j] * u[j]) * w[k][j >> 2][j & 3];
        }
        float bg[8]; unpack8(*(const u32x4*)(UBC + (size_t)row * UBCW + 256 + c), bg);
        u32x4 o;
#pragma unroll
        for (int j = 0; j < 4; ++j) o[j] = pk2(bg[2 * j] * acc[2 * j], bg[2 * j + 1] * acc[2 * j + 1]);
        *(u32x4*)(Y + (size_t)row * DM + 768 + c) = o;
    }
}
DI void phase_mix(const Params& p, int l, float* tab) {
    const int tid = ltid(); unsigned char* ws = p.ws;
    const float* rpb = p.in[I_RPB] + (size_t)l * 6 * 15 * 31;
    for (int i = tid; i < 90 * RPB_PITCH; i += 512) { const int ri = i / RPB_PITCH, dc = i % RPB_PITCH - RPB_SHIFT; tab[i] = (dc >= 0 && dc < 31) ? rpb[ri * 31 + dc] : 0.f; }
    __syncthreads();
    const bf16_t* QK = (const bf16_t*)(ws + WS_QK); const bf16_t* VT = (const bf16_t*)(ws + WS_VT); const bf16_t* UBC = (const bf16_t*)(ws + WS_UBC); bf16_t* Y = (bf16_t*)(ws + WS_Y);
    const float* sink = p.in[I_SINK] + l * 6; const float* cw = p.in[I_CONVC] + l * 3 * 256;
    const int gw = blockIdx.x * 8 + (tid >> 6), nw = gridDim.x * 8;
    const int n_att = l == 0 ? 6144 * 2 + 768 : 6144 * 2; const int n_sc = l == 0 ? MT / 64 : ML / 64;
#pragma unroll 1
    for (int item = gw; item < n_att + n_sc; item += nw) {
        if (item < n_att) { const int type = item < 6144 ? 0 : (item < 12288 ? 1 : (item < 12288 + 384 ? 2 : 3));
            const int idx = item < 6144 ? item : (item < 12288 ? item - 6144 : (item < 12288 + 384 ? item - 12288 : item - 12288 - 384));
            attn_item(tid & 63, type, idx, QK, VT, Y, tab, sink); }
        else sconv_item(tid & 63, item - n_att, UBC, Y, cw);
    }
}

constexpr int NPH = 23;
#ifndef MK_MULTI
#define MK_MULTI 0
#endif
__global__ void __launch_bounds__(512, 2) mega_fwd(Params p) {
    extern __shared__ __attribute__((aligned(16))) unsigned char lds[];
    cg::grid_group grid = cg::this_grid();
    const int G = gridDim.x, bx = blockIdx.x;
    PG8_LAS unsigned char* ldsl = (PG8_LAS unsigned char*)lds;
#define RUN(k) ((k) >= p.ph_lo && (k) < p.ph_hi)
#define SEAM(k) do { if ((k) + 1 < p.ph_hi) grid.sync(); } while (0)
#define LAUNDER(ws, l) unsigned char* ws = p.ws; int l = l0; asm volatile("" : "+s"(ws), "+s"(l))
    if (RUN(0)) { phase_prep(p, (float*)lds); SEAM(0); }
#pragma unroll 1
    for (int l0 = 0; l0 < 2; ++l0) {
        const int pb = 1 + 11 * l0;
        if (RUN(pb + 0)) { LAUNDER(ws, l);
            phase_prenorm(l == 0 ? p.in[I_X] : p.out, l == 0 ? p.in[I_CTX] : (const float*)(ws + WS_RC), p.in[I_GATTN] + l * DM, (const float*)(ws + WS_MOD) + (size_t)l * 9 * MODW, 0, DM, (bf16_t*)(ws + WS_H), MT); SEAM(pb + 0); }
        if (RUN(pb + 1)) { LAUNDER(ws, l);
            const bf16_t* H = (const bf16_t*)(ws + WS_H); const bf16_t* WinT = (const bf16_t*)(ws + WS_WIN + l * SZ_WIN);
            const float* ropec = (const float*)(ws + WS_ROPE);
            { pg8::Gemm g{H, WinT, MT, 2048, DM}; pg8::StaticOrder S; S.init(MT, 2048, G, bx);
              pg8::EpiInProj E{(bf16_t*)(ws + WS_QK), (bf16_t*)(ws + WS_UBC), (const float*)(ws + WS_NG) + l * 256, ropec, ropec + 1024};
              pg8::gemm_phase<pg8::EpiInProj, pg8::StaticOrder, false>(ldsl, g, S, E, nullptr); }
            { pg8::Gemm g{WinT + (size_t)2048 * DM, H, VTR, MT, DM}; pg8::StaticOrder S; S.init(VTR, MT, G, bx);
              pg8::EpiBf16Plain E{(bf16_t*)(ws + WS_VT), (size_t)MT};
              pg8::gemm_phase<pg8::EpiBf16Plain, pg8::StaticOrder, false>(ldsl, g, S, E, nullptr); }
            SEAM(pb + 1);
        }
        if (RUN(pb + 2)) { phase_mix(p, l0, (float*)lds); SEAM(pb + 2); }
        if (RUN(pb + 3)) { LAUNDER(ws, l);
            const int M = l == 0 ? MT : ML; float* RC = (float*)(ws + WS_RC);
            pg8::Gemm g{(const bf16_t*)(ws + WS_Y), (const bf16_t*)(ws + WS_WO + l * SZ_WO), M, DM, DM}; pg8::StaticOrder S; S.init(M, DM, G, bx);
            pg8::EpiResid E{l == 0 ? p.in[I_X] : p.out, l == 0 ? p.in[I_CTX] : RC, p.out, RC, (const float*)(ws + WS_MOD) + (size_t)l * 9 * MODW + 2 * DM, 0};
            pg8::gemm_phase<pg8::EpiResid, pg8::StaticOrder, false>(ldsl, g, S, E, nullptr);
            SEAM(pb + 3);
        }
        if (RUN(pb + 4)) { LAUNDER(ws, l);
            phase_prenorm(p.out, (const float*)(ws + WS_RC), p.in[I_GFFN] + l * DM, (const float*)(ws + WS_MOD) + (size_t)l * 9 * MODW, 3 * DM, 4 * DM, (bf16_t*)(ws + WS_H), l == 0 ? MT : ML); SEAM(pb + 4); }
#pragma unroll 1
        for (int ch = 0; ch < 2; ++ch) {
            const int row0 = ch * 16384; const int rows = ch == 0 ? 16384 : (l0 == 0 ? MT - 16384 : ML - 16384);
            const int pk = pb + 5 + 3 * ch;
            if (RUN(pk + 0)) { LAUNDER(ws, l);
                pg8::Gemm g{(const bf16_t*)(ws + WS_H) + (size_t)row0 * DM, (const bf16_t*)(ws + WS_WUP + l * SZ_WUP), rows, UPW, DM}; pg8::StaticOrder S; S.init(rows, UPW, G, bx);
                pg8::EpiBf16Plain E{(bf16_t*)(ws + WS_UP), (size_t)UPW};
                pg8::gemm_phase<pg8::EpiBf16Plain, pg8::StaticOrder, false>(ldsl, g, S, E, nullptr);
                SEAM(pk + 0);
            }
            if (RUN(pk + 1)) { LAUNDER(ws, l); phase_convact((const bf16_t*)(ws + WS_UP), (bf16_t*)(ws + WS_ACT), p.in[I_CONVF] + (size_t)l * 3 * UPW, row0, rows); SEAM(pk + 1); }
            if (RUN(pk + 2)) { LAUNDER(ws, l); float* RC = (float*)(ws + WS_RC);
                pg8::Gemm g{(const bf16_t*)(ws + WS_ACT), (const bf16_t*)(ws + WS_WD + l * SZ_WD), rows, DM, DFF}; pg8::StaticOrder S; S.init(rows, DM, G, bx);
                pg8::EpiResid E{p.out, RC, p.out, RC, (const float*)(ws + WS_MOD) + (size_t)l * 9 * MODW + 5 * DM, row0};
                pg8::gemm_phase<pg8::EpiResid, pg8::StaticOrder, false>(ldsl, g, S, E, nullptr);
                if (ch == 1) SEAM(pk + 2);
            }
        }
    }
}

extern "C" void kernel_launch(void* const* d_in, const int* in_sizes, int n_in, void* d_out, int out_size, void* d_ws, size_t ws_size, hipStream_t stream) {
    static int grid = 0;
    if (grid == 0) {
        if (n_in != 20 || out_size != ML * DM || ws_size < WS_END) { fprintf(stderr, "kernel_launch: unexpected shapes (n_in %d out %d ws %zu need %zu)\n", n_in, out_size, ws_size, (size_t)WS_END); grid = -1; return; }
        int dev = 0, cus = 0, per_cu = 0;
        (void)hipGetDevice(&dev); (void)hipDeviceGetAttribute(&cus, hipDeviceAttributeMultiprocessorCount, dev);
        if (hipFuncSetAttribute((const void*)mega_fwd, hipFuncAttributeMaxDynamicSharedMemorySize, LDS_BYTES) != hipSuccess) { fprintf(stderr, "kernel_launch: hipFuncSetAttribute failed\n"); grid = -1; return; }
        if (hipOccupancyMaxActiveBlocksPerMultiprocessor(&per_cu, (const void*)mega_fwd, 512, LDS_BYTES) != hipSuccess || per_cu < 1) { fprintf(stderr, "kernel_launch: occupancy query failed (%d)\n", per_cu); (void)hipGetLastError(); per_cu = 1; }
        grid = cus * per_cu;
        fprintf(stderr, "kernel_launch: grid %d (cus %d x %d)\n", grid, cus, per_cu);
    }
    if (grid < 0) return;
    Params p{};
    for (int i = 0; i < 20; ++i) p.in[i] = (const float*)d_in[i];
    p.out = (float*)d_out; p.ws = (unsigned char*)d_ws;
#if MK_MULTI
    for (int k = 0; k < NPH; ++k) { p.ph_lo = k; p.ph_hi = k + 1; hipLaunchKernelGGL(mega_fwd, dim3(grid), dim3(512), LDS_BYTES, stream, p); }
#else
    p.ph_lo = 0; p.ph_hi = NPH;
    void* args[] = {&p};
    hipError_t e = hipLaunchCooperativeKernel((const void*)mega_fwd, dim3(grid), dim3(512), args, LDS_BYTES, stream);
    if (e != hipSuccess) fprintf(stderr, "kernel_launch: cooperative launch failed: %s (grid %d)\n", hipGetErrorString(e), grid);
#endif
}
```

```cpp
#include <hip/hip_runtime.h>
#include <hip/hip_cooperative_groups.h>
#include <cstdio>
namespace cg = cooperative_groups;
#define DI __device__ __forceinline__
typedef float f32x16 __attribute__((ext_vector_type(16)));
typedef unsigned u32x2 __attribute__((ext_vector_type(2)));
typedef unsigned u32x4 __attribute__((ext_vector_type(4)));

constexpr int DM = 1024, NBATCH = 8, SEQL = 4096, CTXL = 256;
constexpr int ML = NBATCH * SEQL, MC = NBATCH * CTXL, MT = ML + MC;
constexpr int INW = 2560, DFF = 2816, UPW = 5632, MODW = 6144;
constexpr int QKW = 1280;
constexpr int UBCW = 768;
constexpr int VTR = 512;
constexpr float EPSN = 1e-6f;
constexpr int LDS_STAGE = 131072;
constexpr int LDS_TAB = LDS_STAGE + 16;
constexpr int LDS_BYTES = LDS_TAB + 91 * 80 * 4;

constexpr size_t SZ_WIN = (size_t)INW * DM * 2, SZ_WO = (size_t)DM * DM * 2, SZ_WUP = (size_t)UPW * DM * 2, SZ_WD = (size_t)DM * DFF * 2;
constexpr size_t WS_WIN = 0;
constexpr size_t WS_WO = WS_WIN + 2 * SZ_WIN;
constexpr size_t WS_WUP = WS_WO + 2 * SZ_WO;
constexpr size_t WS_WD = WS_WUP + 2 * SZ_WUP;
constexpr size_t WS_MOD = WS_WD + 2 * SZ_WD;
constexpr size_t WS_ROPE = WS_MOD + (size_t)2 * 9 * MODW * 4;
constexpr size_t WS_NG = WS_ROPE + 8192;
constexpr size_t WS_SM = WS_NG + 2048;
constexpr size_t WS_BAR = WS_SM + 256;
constexpr size_t WS_BAR_BYTES = 16384;
constexpr size_t WS_RB = WS_BAR + WS_BAR_BYTES;
constexpr size_t WS_X = WS_RB + (size_t)MT * DM * 2;
constexpr size_t WS_QK = WS_X;
constexpr size_t WS_UBC = WS_QK + (size_t)MT * QKW * 2;
constexpr size_t WS_VT = WS_UBC + (size_t)MT * UBCW * 2;
constexpr size_t WS_KB = WS_VT + (size_t)VTR * MT * 2;
constexpr size_t WS_Y = WS_KB + (size_t)8 * MT * 64 * 2;
constexpr size_t WS_ACT = WS_X;
constexpr size_t WS_UPB = WS_ACT + (size_t)MT * DFF * 2;
constexpr size_t WS_END_A = WS_Y + (size_t)MT * DM * 2, WS_END_B = WS_UPB + (size_t)(MT / 64) * 4 * UPW * 2;
constexpr size_t WS_PART = WS_END_A > WS_END_B ? WS_END_A : WS_END_B;
constexpr int PART_MAX = 11;
constexpr size_t WS_END = WS_PART + (size_t)PART_MAX * MC * DM * 4;

DI unsigned pk2(float lo, float hi) {
    typedef __bf16 bf2 __attribute__((ext_vector_type(2))); typedef float f2 __attribute__((ext_vector_type(2)));
    f2 v = {lo, hi}; bf2 r = __builtin_convertvector(v, bf2); return __builtin_bit_cast(unsigned, r);
}
DI float shx(float v, int o, int lane) { return __int_as_float(__builtin_amdgcn_ds_bpermute((lane ^ o) << 2, __float_as_int(v))); }
DI float bflo(unsigned u) { return __uint_as_float(u << 16); }
DI float bfhi(unsigned u) { return __uint_as_float(u & 0xffff0000u); }

namespace pg8 {
#define PG8_LAS __attribute__((address_space(3)))
typedef unsigned short bf16_t;
typedef short bf16x8 __attribute__((ext_vector_type(8)));
typedef float f32x4 __attribute__((ext_vector_type(4)));
typedef unsigned u32x4 __attribute__((ext_vector_type(4)));
constexpr int BM = 256, BK = 64, HALF = 128, HTB = HALF * BK * 2  , STAGE_BYTES = 8 * HTB, NXCD = 8, WGM = 8;

__host__ __device__ __forceinline__ int lds_byte(int r, int c) { const int st = (r >> 4) * 2 + (c >> 5), rr = r & 15, cc = c & 31, ob = rr * 64 + cc * 2; return st * 1024 + (ob ^ (((ob >> 9) & 1) << 5)); }
__host__ __device__ __forceinline__ void stage_rc(int b, int& R, int& C) { const int st = b / 1024, sb = b % 1024, swz = sb ^ (((sb >> 9) & 1) << 5); R = (st >> 1) * 16 + swz / 64; C = (st & 1) * 32 + (swz % 64) / 2; }
__host__ __device__ __forceinline__ int perm32(int rho) { const int n = rho >> 4, i = rho & 15; return 8 * (i >> 2) + 4 * n + (i & 3); }

struct Unit { int pm, pn, seg, kt0, nt; };
struct Gemm { const bf16_t* A; const bf16_t* Bt; int M, N, K, wv; };

struct StaticOrder {
    int nM, nN, nwg, G, c, ntk;
    __host__ __device__ void init(int M, int N, int G_, int c_) { nM = M / BM; nN = N / BM; nwg = nM * nN; G = G_; c = c_; ntk = 0; }
    __device__ __forceinline__ const char* a_ptr(const Gemm& g, const Unit& u) const { return (const char*)g.A + (size_t)u.pm * ((size_t)BM * g.K * 2); }
    __device__ __forceinline__ const char* b_ptr(const Gemm& g, const Unit& u) const { return (const char*)g.Bt + (size_t)u.pn * ((size_t)BM * g.K * 2); }
    __host__ __device__ bool next(int i, Unit& u) const {
        const long L = (long)i * G + c; if (L >= nwg) return false;
        int wgid = (int)L; { const int q = nwg / NXCD, r = nwg % NXCD, xcd = wgid % NXCD, off = wgid / NXCD; wgid = (xcd < r ? xcd * (q + 1) : r * (q + 1) + (xcd - r) * q) + off; }
        const int nig = WGM * nN, gid = wgid / nig, fm = gid * WGM, gsz = (nM - fm) < WGM ? (nM - fm) : WGM;
        u.pm = fm + ((wgid % nig) % gsz); u.pn = (wgid % nig) / gsz; u.seg = 0; u.kt0 = 0; u.nt = ntk; return true;
    }
    __device__ __forceinline__ void a_ready(const Unit&) const {}
    __device__ __forceinline__ void done(const Unit&) const {}
};

struct TwoSegOrder {
    StaticOrder s0; int n0, nM1, nN1, S, nt0, nt1, n1; const char* A1; const char* B1;
    __device__ void init(int M0, int N0, int K0tiles, const void* A1_, const void* B1_, int M1, int N1, int S_, int nt1_, int G_, int c_) {
        s0.init(M0, N0, G_, c_); s0.ntk = K0tiles; n0 = s0.nwg; nt0 = K0tiles; A1 = (const char*)A1_; B1 = (const char*)B1_; nM1 = M1 / BM; nN1 = N1 / BM; S = S_; nt1 = nt1_; n1 = nM1 * nN1 * S; }
    __device__ bool next(int i, Unit& u) const {
        const long L = (long)i * s0.G + s0.c;
        if (L < n0) return s0.next(i, u);
        const int w = (int)(L - n0); if (w >= n1) return false;
        const int tile = w / S, sp = w - tile * S; u.pm = tile / nN1; u.pn = tile - u.pm * nN1; u.seg = 1; u.kt0 = sp * nt1; u.nt = nt1; return true;
    }
    __device__ __forceinline__ const char* a_ptr(const Gemm& g, const Unit& u) const { return (u.seg ? A1 : (const char*)g.A) + (size_t)u.pm * ((size_t)BM * g.K * 2) + (size_t)u.kt0 * (BK * 2); }
    __device__ __forceinline__ const char* b_ptr(const Gemm& g, const Unit& u) const { return (u.seg ? B1 : (const char*)g.Bt) + (size_t)u.pn * ((size_t)BM * g.K * 2) + (size_t)u.kt0 * (BK * 2); }
    __device__ __forceinline__ void a_ready(const Unit&) const {}
    __device__ __forceinline__ void done(const Unit&) const {}
};
struct EpiBf16Plain {
    static constexpr bool PERM = true, AFTER_DRAIN = false, APERM = false;
    bf16_t* O; size_t ldc;
    __device__ __forceinline__ void operator()(const f32x4 (&acc)[2][2][4][2], const Unit& u, int wr, int wc, int fr, int fq) const {
        const int row0 = u.pm * BM + wr * 64 + fr, col0 = u.pn * BM + wc * 32 + 8 * fq;
#pragma unroll
        for (int ai = 0; ai < 2; ++ai)
#pragma unroll
            for (int m = 0; m < 4; ++m) { bf16_t* rowp = O + (size_t)(row0 + ai * HALF + m * 16) * ldc + col0;
#pragma unroll
                for (int bj = 0; bj < 2; ++bj) { const f32x4 v0 = acc[ai][bj][m][0], v1 = acc[ai][bj][m][1];
                    u32x4 o; o[0] = pk2(v0[0], v0[1]); o[1] = pk2(v0[2], v0[3]); o[2] = pk2(v1[0], v1[1]); o[3] = pk2(v1[2], v1[3]);
                    *(u32x4*)(rowp + bj * HALF) = o; } }
    }
};
struct EpiResid {
    static constexpr bool PERM = false, AFTER_DRAIN = false, APERM = false;
    const void* src; void* dst; int src_bf16, dst_bf16; bf16_t* PART; const float* gate;
    __device__ __forceinline__ void operator()(const f32x4 (&acc)[2][2][4][2], const Unit& u, int wr, int wc, int fr, int fq) const {
        const int rbase = u.pm * BM; const int b = u.seg ? 8 : (rbase >> 12);
        const int col0 = u.pn * BM + wc * 32 + 8 * fq;
        f32x4 gv[2][2];
#pragma unroll
        for (int bj = 0; bj < 2; ++bj)
#pragma unroll
            for (int n = 0; n < 2; ++n) gv[bj][n] = *(const f32x4*)(gate + (size_t)b * MODW + col0 + bj * HALF + n * 4);
        if (u.seg) {
            bf16_t* pp = PART + (size_t)(u.kt0 / u.nt) * ((size_t)MC * DM);
#pragma unroll
            for (int ai = 0; ai < 2; ++ai)
#pragma unroll
                for (int m = 0; m < 4; ++m) { bf16_t* dp = pp + (size_t)(rbase + wr * 64 + fr + ai * HALF + m * 16) * DM + col0;
#pragma unroll
                    for (int bj = 0; bj < 2; ++bj) { const f32x4 v0 = gv[bj][0] * acc[ai][bj][m][0], v1 = gv[bj][1] * acc[ai][bj][m][1]; u32x4 ob;
                        ob[0] = pk2(v0[0], v0[1]); ob[1] = pk2(v0[2], v0[3]); ob[2] = pk2(v1[0], v1[1]); ob[3] = pk2(v1[2], v1[3]); *(u32x4*)(dp + bj * HALF) = ob; } }
            return;
        }
        if (dst_bf16) body<1>(acc, gv, rbase, col0, wr, fr); else body<0>(acc, gv, rbase, col0, wr, fr);
    }
    template <int DB> __device__ __forceinline__ void body(const f32x4 (&acc)[2][2][4][2], const f32x4 (&gv)[2][2], int rbase, int col0, int wr, int fr) const {
        constexpr int MG = DB ? 4 : 2;
        const bf16_t* sp = (DB ? (const bf16_t*)dst : (const bf16_t*)src) + (size_t)(rbase + wr * 64 + fr) * DM + col0;
#pragma unroll
        for (int ai = 0; ai < 2; ++ai)
#pragma unroll
            for (int m0 = 0; m0 < 4; m0 += MG) {
                u32x4 rb[MG][2];
#pragma unroll
                for (int mm = 0; mm < MG; ++mm)
#pragma unroll
                    for (int bj = 0; bj < 2; ++bj) rb[mm][bj] = *(const u32x4*)(sp + (size_t)(ai * HALF + (m0 + mm) * 16) * DM + bj * HALF);
#pragma unroll
                for (int mm = 0; mm < MG; ++mm)
#pragma unroll
                    for (int bj = 0; bj < 2; ++bj) { const int m = m0 + mm; const u32x4 q = rb[mm][bj]; f32x4 r0, r1;
                        r0[0] = bflo(q[0]); r0[1] = bfhi(q[0]); r0[2] = bflo(q[1]); r0[3] = bfhi(q[1]); r1[0] = bflo(q[2]); r1[1] = bfhi(q[2]); r1[2] = bflo(q[3]); r1[3] = bfhi(q[3]);
                        const f32x4 v0 = r0 + gv[bj][0] * acc[ai][bj][m][0], v1 = r1 + gv[bj][1] * acc[ai][bj][m][1];
                        if (DB) { u32x4 ob; ob[0] = pk2(v0[0], v0[1]); ob[1] = pk2(v0[2], v0[3]); ob[2] = pk2(v1[0], v1[1]); ob[3] = pk2(v1[2], v1[3]);
                            *(u32x4*)(const_cast<bf16_t*>(sp) + (size_t)(ai * HALF + m * 16) * DM + bj * HALF) = ob; }
                        else { const size_t o = (size_t)(rbase + wr * 64 + fr + ai * HALF + m * 16) * DM + col0 + bj * HALF; *(f32x4*)((float*)dst + o) = v0; *(f32x4*)((float*)dst + o + 4) = v1; } }
                __builtin_amdgcn_sched_barrier(0);
            }
    }
};
struct EpiInProj {
    static constexpr bool PERM = true, AFTER_DRAIN = false, APERM = false;
    bf16_t* QK; bf16_t* KB; bf16_t* UBC; bf16_t* VT; const float* ng; const PG8_LAS float* ropec; const PG8_LAS float* ropes;
    __device__ __forceinline__ void operator()(const f32x4 (&acc)[2][2][4][2], const Unit& u, int wr, int wc, int fr, int fq) const {
        if (u.seg) {
            const int r0v = u.pm * BM + wr * 64 + fr, c0v = u.pn * BM + wc * 32 + 8 * fq;
#pragma unroll
            for (int ai = 0; ai < 2; ++ai)
#pragma unroll
                for (int m = 0; m < 4; ++m) { const int r = r0v + ai * HALF + m * 16;
#pragma unroll
                    for (int bj = 0; bj < 2; ++bj) { const f32x4 v0 = acc[ai][bj][m][0], v1 = acc[ai][bj][m][1]; const int c = c0v + bj * HALF; u32x4 o;
                        o[0] = pk2(v0[0], v0[1]); o[1] = pk2(v0[2], v0[3]); o[2] = pk2(v1[0], v1[1]); o[3] = pk2(v1[2], v1[3]);
                        *(u32x4*)(VT + (((size_t)(r >> 6) * (MT / 8) + (c >> 3)) * 64 + (r & 63)) * 8) = o; } }
            return;
        }
        const int row0 = u.pm * BM + wr * 64 + fr;
        if (u.pn >= 5) {
            const int col0 = (u.pn - 5) * BM + wc * 32 + 8 * fq;
#pragma unroll
            for (int ai = 0; ai < 2; ++ai)
#pragma unroll
                for (int m = 0; m < 4; ++m) { bf16_t* rowp = UBC + (size_t)(row0 + ai * HALF + m * 16) * UBCW + col0;
#pragma unroll
                    for (int bj = 0; bj < 2; ++bj) { const f32x4 v0 = acc[ai][bj][m][0], v1 = acc[ai][bj][m][1]; u32x4 o;
                        o[0] = pk2(v0[0], v0[1]); o[1] = pk2(v0[2], v0[3]); o[2] = pk2(v1[0], v1[1]); o[3] = pk2(v1[2], v1[3]);
                        *(u32x4*)(rowp + bj * HALF) = o; } }
            return;
        }
        const int Hh = 4 * u.pn + wc;
        const float* g = ng + 64 * (Hh < 6 ? 0 : (Hh < 12 ? 1 : (Hh < 18 ? 2 : 3)));
        const float qs = (Hh < 6 || (Hh >= 12 && Hh < 18)) ? 0.125f * 1.4426950408889634f : 1.0f;
        const bool rope = Hh >= 12;
        f32x4 gv[2][2];
#pragma unroll
        for (int bj = 0; bj < 2; ++bj)
#pragma unroll
            for (int n = 0; n < 2; ++n) gv[bj][n] = *(const f32x4*)(g + bj * 32 + 8 * fq + 4 * n) * qs;
#pragma unroll
        for (int ai = 0; ai < 2; ++ai)
#pragma unroll
            for (int m = 0; m < 4; ++m) {
                const int row = row0 + ai * HALF + m * 16;
                float ss = 0.f;
#pragma unroll
                for (int bj = 0; bj < 2; ++bj)
#pragma unroll
                    for (int n = 0; n < 2; ++n) { const f32x4 v = acc[ai][bj][m][n]; ss += v[0] * v[0] + v[1] * v[1] + v[2] * v[2] + v[3] * v[3]; }
                ss += shx(ss, 16, fr + 16 * fq); ss += shx(ss, 32, fr + 16 * fq);
                const float rstd = rsqrtf(ss * (1.0f / 64.0f) + EPSN);
                f32x4 y[2][2];
#pragma unroll
                for (int bj = 0; bj < 2; ++bj)
#pragma unroll
                    for (int n = 0; n < 2; ++n) y[bj][n] = acc[ai][bj][m][n] * rstd * gv[bj][n];
                if (rope && row < ML) {
                    const int t = row & (SEQL - 1); const int pos = fq < 2 ? (t >> 6) : (t & 63);
#pragma unroll
                    for (int n = 0; n < 2; ++n) {
                        const f32x4 c4 = *(const PG8_LAS f32x4*)(ropec + pos * 16 + 8 * (fq & 1) + 4 * n), s4 = *(const PG8_LAS f32x4*)(ropes + pos * 16 + 8 * (fq & 1) + 4 * n);
                        const f32x4 x1 = y[0][n], x2 = y[1][n];
                        y[0][n] = x1 * c4 - x2 * s4; y[1][n] = x2 * c4 + x1 * s4; }
                }
                const bool isk = (Hh >= 6 && Hh < 12) || Hh >= 18;
                bf16_t* rowp = isk ? KB + (((size_t)(Hh < 12 ? Hh - 6 : Hh - 12) * (MT / 8) + (row >> 3)) * 8 + (fq >> 1) * 2 + (fq & 1)) * 64 + (row & 7) * 8
                                   : QK + ((size_t)row * 20 + Hh) * 64 + 8 * fq;
                const int sb = isk ? 256 : 32;
#pragma unroll
                for (int bj = 0; bj < 2; ++bj) { const f32x4 v0 = y[bj][0], v1 = y[bj][1]; u32x4 o;
                    o[0] = pk2(v0[0], v0[1]); o[1] = pk2(v0[2], v0[3]); o[2] = pk2(v1[0], v1[1]); o[3] = pk2(v1[2], v1[3]);
                    *(u32x4*)(rowp + bj * sb) = o; }
            }
    }
};
__device__ __forceinline__ float dpp_shr1(float v) { return __int_as_float(__builtin_amdgcn_update_dpp(0, __float_as_int(v), 0x111, 0xf, 0xf, true)); }
__device__ __forceinline__ float dpp_shl1(float v) { return __int_as_float(__builtin_amdgcn_update_dpp(0, __float_as_int(v), 0x101, 0xf, 0xf, true)); }
struct EpiUpConv {
    static constexpr bool PERM = false, AFTER_DRAIN = false, APERM = true;
    bf16_t* ACT; bf16_t* UPB; const float* cw;
    __device__ __forceinline__ void operator()(const f32x4 (&acc)[2][2][4][2], const Unit& u, int wr, int wc, int fr, int fq) const {
        const int ch0 = 128 * u.pn + 32 * wc + 8 * fq;
        f32x4 wa[2][3], wg[2][3];
#pragma unroll
        for (int n = 0; n < 2; ++n)
#pragma unroll
            for (int k = 0; k < 3; ++k) { wa[n][k] = *(const f32x4*)(cw + k * UPW + ch0 + 4 * n); wg[n][k] = *(const f32x4*)(cw + k * UPW + DFF + ch0 + 4 * n); }
#pragma unroll
        for (int ai = 0; ai < 2; ++ai) {
            const int rbase = u.pm * BM + ai * HALF + wr * 64;
            u32x4 o[4];
#pragma unroll
            for (int n = 0; n < 2; ++n) {
                f32x4 pa, pg, na, ng2;
#pragma unroll
                for (int e2 = 0; e2 < 4; ++e2) { pa[e2] = dpp_shr1(acc[ai][0][3][n][e2]); pg[e2] = dpp_shr1(acc[ai][1][3][n][e2]); na[e2] = dpp_shl1(acc[ai][0][0][n][e2]); ng2[e2] = dpp_shl1(acc[ai][1][0][n][e2]); }
#pragma unroll
                for (int m = 0; m < 4; ++m) {
                    const f32x4 xa = acc[ai][0][m][n], xg = acc[ai][1][m][n];
                    const f32x4 ya = m > 0 ? acc[ai][0][m > 0 ? m - 1 : 0][n] : pa, yg = m > 0 ? acc[ai][1][m > 0 ? m - 1 : 0][n] : pg;
                    const f32x4 za = m < 3 ? acc[ai][0][m < 3 ? m + 1 : 3][n] : na, zg = m < 3 ? acc[ai][1][m < 3 ? m + 1 : 3][n] : ng2;
                    const f32x4 a = wa[n][0] * ya + wa[n][1] * xa + wa[n][2] * za, g = wg[n][0] * yg + wg[n][1] * xg + wg[n][2] * zg;
                    float r[4];
#pragma unroll
                    for (int e2 = 0; e2 < 4; ++e2) r[e2] = a[e2] * __builtin_amdgcn_rcpf(1.0f + __expf(-a[e2])) * g[e2];
                    o[m][2 * n] = pk2(r[0], r[1]); o[m][2 * n + 1] = pk2(r[2], r[3]);
                }
            }
#pragma unroll
            for (int m = 0; m < 4; ++m) {
                const bool edge = (m == 0 && fr == 0) || (m == 3 && fr == 15);
                if (!edge) *(u32x4*)(ACT + (size_t)(rbase + 4 * fr + m) * DFF + ch0) = o[m];
            }
            if (fr == 0 || fr == 15) {
#pragma unroll
                for (int j = 0; j < 2; ++j) { const int m = fr == 0 ? j : 2 + j; bf16_t* up = UPB + ((size_t)(rbase >> 6) * 4 + (fr == 0 ? j : 2 + j)) * UPW + ch0;
#pragma unroll
                    for (int bj = 0; bj < 2; ++bj) { const f32x4 v0 = fr == 0 ? acc[ai][bj][j][0] : acc[ai][bj][2 + j][0], v1 = fr == 0 ? acc[ai][bj][j][1] : acc[ai][bj][2 + j][1]; u32x4 ro; (void)m;
                        ro[0] = pk2(v0[0], v0[1]); ro[1] = pk2(v0[2], v0[3]); ro[2] = pk2(v1[0], v1[1]); ro[3] = pk2(v1[2], v1[3]);
                        *(u32x4*)(up + bj * DFF) = ro; } }
            }
        }
    }
};
template <class Epi, class Sched, bool STAMP = false>
__device__ __forceinline__ void gemm_phase(PG8_LAS unsigned char* lds, const Gemm g, const Sched& S, const Epi& E, unsigned long long* stamps) {
    int lane_; asm volatile("v_mbcnt_lo_u32_b32 %0, -1, 0\n\tv_mbcnt_hi_u32_b32 %0, -1, %0" : "=v"(lane_)); const int tid = g.wv * 64 + lane_, wid = __builtin_amdgcn_readfirstlane(tid >> 6), lane = tid & 63, wr = wid >> 2, wc = wid & 3, fr = lane & 15, fq = lane >> 4;
    const int K = g.K;
    int ts_lo = 0, ts_hi = 0, nts = 0; const unsigned long long rt_entry = STAMP ? (unsigned long long)wall_clock64() : 0ull;
#define PG8_STAMP() do { if (STAMP && wid == 0 && nts < 64) { const unsigned long long _c = (unsigned long long)clock64(); \
        ts_lo = (lane == nts) ? (int)(unsigned)_c : ts_lo; ts_hi = (lane == nts) ? (int)(unsigned)(_c >> 32) : ts_hi; ++nts; } } while (0)
    PG8_STAMP();
    unsigned voffA[2], voffB[2];
#pragma unroll
    for (int i = 0; i < 2; ++i) { int R, C; stage_rc(tid * 16 + i * 8192, R, C); const int Rb = Epi::PERM ? ((R & ~31) + perm32(R & 31)) : R;
        const int Ra = Epi::APERM ? ((R & ~63) + 4 * (R & 15) + ((R >> 4) & 3)) : R;
        voffA[i] = (unsigned)(Ra * K + C) * 2u; voffB[i] = (unsigned)(Rb * K + C) * 2u; }
    const size_t kstep = (size_t)(BK * 2);
    const size_t hstep = (size_t)HALF * K * 2;
    const size_t tstep = 2 * hstep;
    const unsigned ldsw = (unsigned)wid * 1024u;
    const int aoff = lds_byte(wr * 64 + fr, fq * 8), boff = lds_byte(wc * 32 + fr, fq * 8);
#define PG8_SA(b, h) (((b) * 2 + (h)) * HTB)
#define PG8_SB(b, h) ((4 + (b) * 2 + (h)) * HTB)
#define PG8_STAGE(bufoff, gbase, voff) do { _Pragma("unroll") for (int _i = 0; _i < 2; ++_i) \
        __builtin_amdgcn_global_load_lds((const unsigned*)((const char*)(gbase) + (voff)[_i]), (PG8_LAS unsigned*)(lds + (bufoff) + ldsw + _i * 8192), 16, 0, 0); } while (0)
#define PG8_LDA(dst, b, h) do { _Pragma("unroll") for (int m = 0; m < 4; ++m) _Pragma("unroll") for (int k = 0; k < 2; ++k) dst[m][k] = *(const PG8_LAS bf16x8*)(lds + PG8_SA(b, h) + aoff + m * 2048 + k * 1024); } while (0)
#define PG8_LDB(dst, b, h) do { _Pragma("unroll") for (int n = 0; n < 2; ++n) _Pragma("unroll") for (int k = 0; k < 2; ++k) dst[n][k] = *(const PG8_LAS bf16x8*)(lds + PG8_SB(b, h) + boff + n * 2048 + k * 1024); } while (0)
#define PG8_MMA(ai, bj, At, Bt) do { __builtin_amdgcn_s_setprio(1); _Pragma("unroll") for (int m = 0; m < 4; ++m) _Pragma("unroll") for (int n = 0; n < 2; ++n) _Pragma("unroll") for (int k = 0; k < 2; ++k) \
        acc[ai][bj][m][n] = __builtin_amdgcn_mfma_f32_16x16x32_bf16(Bt[n][k], At[m][k], acc[ai][bj][m][n], 0, 0, 0); __builtin_amdgcn_s_setprio(0); } while (0)
#define PG8_WAIT_V(n) asm volatile("s_waitcnt vmcnt(" #n ")" ::: "memory")
#define PG8_WAIT_L(n) asm volatile("s_waitcnt lgkmcnt(" #n ")" ::: "memory")
#define PG8_BAR __builtin_amdgcn_s_barrier()
#define PG8_SCHED __builtin_amdgcn_sched_barrier(0)
    Unit cur, nxt; int ui = 0;
    if (!S.next(0, cur)) return;
    f32x4 acc[2][2][4][2];
#pragma unroll
    for (int a = 0; a < 2; ++a)
#pragma unroll
        for (int b = 0; b < 2; ++b)
#pragma unroll
            for (int m = 0; m < 4; ++m)
#pragma unroll
                for (int n = 0; n < 2; ++n) acc[a][b][m][n] = (f32x4){0.f, 0.f, 0.f, 0.f};
    bf16x8 At[4][2], B0[2][2], B1[2][2];
    const char* cA = S.a_ptr(g, cur); const char* cB = S.b_ptr(g, cur);
    S.a_ready(cur);
    PG8_STAGE(PG8_SB(0, 0), cB, voffB); PG8_STAGE(PG8_SA(0, 0), cA, voffA); PG8_STAGE(PG8_SB(0, 1), cB + hstep, voffB); PG8_STAGE(PG8_SA(0, 1), cA + hstep, voffA);
    if (wr == 1) PG8_BAR;
    PG8_WAIT_V(4); PG8_BAR;
    PG8_STAGE(PG8_SB(1, 0), cB + kstep, voffB); PG8_STAGE(PG8_SA(1, 0), cA + kstep, voffA); PG8_STAGE(PG8_SB(1, 1), cB + hstep + kstep, voffB);
    PG8_WAIT_V(6); PG8_BAR;
    PG8_STAMP();
    for (;;) {
        const bool has_next = S.next(ui + 1, nxt);
        const char* nA = has_next ? S.a_ptr(g, nxt) : cA; const char* nB = has_next ? S.b_ptr(g, nxt) : cB; const int nt = cur.nt;
        for (int t = 0; t < nt; t += 2) {
            const bool last = (t == nt - 2);
            const char* a1 = cA + (size_t)(t + 1) * kstep;
            const char* a2 = last ? nA : cA + (size_t)(t + 2) * kstep; const char* b2 = last ? nB : cB + (size_t)(t + 2) * kstep;
            const char* a3 = a2 + kstep; const char* b3 = b2 + kstep;
            if (last && has_next) S.a_ready(nxt);
            PG8_LDB(B0, 0, 0); PG8_SCHED; PG8_LDA(At, 0, 0); PG8_STAGE(PG8_SA(1, 1), a1 + hstep, voffA);
            PG8_WAIT_L(8); PG8_BAR; PG8_WAIT_L(0); PG8_MMA(0, 0, At, B0); PG8_BAR; PG8_SCHED;
            PG8_LDB(B1, 0, 1); PG8_STAGE(PG8_SB(0, 0), b2, voffB);
            PG8_BAR; PG8_WAIT_L(0); PG8_MMA(0, 1, At, B1); PG8_BAR;
            PG8_LDA(At, 0, 1); PG8_STAGE(PG8_SA(0, 0), a2, voffA);
            PG8_BAR; PG8_WAIT_L(0); PG8_MMA(1, 0, At, B0); PG8_BAR; PG8_SCHED;
            PG8_STAGE(PG8_SB(0, 1), b2 + hstep, voffB);
            PG8_WAIT_V(6); PG8_BAR; PG8_MMA(1, 1, At, B1); PG8_BAR;
            PG8_LDB(B0, 1, 0); PG8_SCHED; PG8_LDA(At, 1, 0); PG8_STAGE(PG8_SA(0, 1), a2 + hstep, voffA);
            PG8_WAIT_L(8); PG8_BAR; PG8_WAIT_L(0); PG8_MMA(0, 0, At, B0); PG8_BAR; PG8_SCHED;
            PG8_LDB(B1, 1, 1); PG8_STAGE(PG8_SB(1, 0), b3, voffB);
            PG8_BAR; PG8_WAIT_L(0); PG8_MMA(0, 1, At, B1); PG8_BAR;
            PG8_LDA(At, 1, 1); PG8_STAGE(PG8_SA(1, 0), a3, voffA);
            PG8_BAR; PG8_WAIT_L(0); PG8_MMA(1, 0, At, B0); PG8_BAR; PG8_SCHED;
            PG8_STAGE(PG8_SB(1, 1), b3 + hstep, voffB);
            PG8_WAIT_V(6); PG8_BAR; PG8_MMA(1, 1, At, B1); PG8_BAR;
        }
        PG8_STAMP();
        if constexpr (!Epi::AFTER_DRAIN) { E(acc, cur, wr, wc, fr, fq); S.done(cur); }
        PG8_STAMP();
        if (!has_next) break;
#pragma unroll
        for (int a = 0; a < 2; ++a)
#pragma unroll
            for (int b = 0; b < 2; ++b)
#pragma unroll
                for (int m = 0; m < 4; ++m)
#pragma unroll
                    for (int n = 0; n < 2; ++n) acc[a][b][m][n] = (f32x4){0.f, 0.f, 0.f, 0.f};
        cur = nxt; cA = nA; cB = nB; ++ui;
    }
    PG8_WAIT_V(0);
    if (wr == 0) PG8_BAR;
    PG8_BAR;
    if constexpr (Epi::AFTER_DRAIN) { E.fused(acc, cur, wr, wc, fr, fq, lds, wid, lane); S.done(cur); }
    PG8_STAMP();
    if (STAMP && wid == 0) { stamps[lane] = lane < nts ? (((unsigned long long)(unsigned)ts_hi << 32) | (unsigned)ts_lo) : 0ull;
        if (lane == 62) stamps[62] = rt_entry; if (lane == 63) stamps[63] = (unsigned long long)wall_clock64(); }
#undef PG8_STAMP
#undef PG8_SA
#undef PG8_SB
#undef PG8_STAGE
#undef PG8_LDA
#undef PG8_LDB
#undef PG8_MMA
#undef PG8_WAIT_V
#undef PG8_WAIT_L
#undef PG8_BAR
#undef PG8_SCHED
}
}
#define XB_TMO      128
#define XB_XCNT(j)  (256  + 64 * (j))
#define XB_XSUB(j)  (1280 + 64 * (j))
#define XB_XGEN(j)  (2304 + 64 * (j))
#define XB_TOP      3328
#define XB_TOPGEN   3392
#define XCD_BAR_WORDS 3456
#define XB_SPIN_CAP (1u << 18)
#define LAS __attribute__((address_space(3)))

__device__ __forceinline__ unsigned xb_ld(unsigned* p)              { return __hip_atomic_load(p, __ATOMIC_RELAXED, __HIP_MEMORY_SCOPE_AGENT); }
__device__ __forceinline__ unsigned xb_add(unsigned* p, unsigned v) { return __hip_atomic_fetch_add(p, v, __ATOMIC_RELAXED, __HIP_MEMORY_SCOPE_AGENT); }
__device__ __forceinline__ unsigned xb_xcc_id() { return (unsigned)__builtin_amdgcn_s_getreg((3 << 11) | 20) & 0xFu; }
#define XB_SPIN(cond, bar) do { unsigned _sp = 0; while (cond) { __builtin_amdgcn_s_sleep(1); \
    if ((++_sp & 255u) == 0u) { if (xb_ld(&(bar)[XB_TMO])) break; if (_sp > XB_SPIN_CAP) { atomicAdd(&(bar)[XB_TMO], 1u); break; } } } } while (0)

struct XcdBarrier {
    unsigned* bar; unsigned x;
    volatile LAS unsigned* st;
};

__device__ __forceinline__ XcdBarrier xcd_barrier_post(unsigned* bar, volatile LAS unsigned* st) {
    XcdBarrier b; b.bar = bar; b.x = xb_xcc_id(); b.st = st;
    if (threadIdx.x == 0) (void)xb_add(&bar[XB_XCNT(b.x)], 1u);
    return b;
}
__device__ __forceinline__ void xcd_barrier_complete(unsigned* bar, unsigned x, unsigned& nloc, unsigned& nx) {
    const unsigned G = gridDim.x * gridDim.y * gridDim.z;
    unsigned sum, cnt, mine, sp = 0u;
    for (;;) {
        sum = 0u; cnt = 0u; mine = 0u;
#pragma unroll
        for (unsigned j = 0; j < 16; ++j) { const unsigned c = xb_ld(&bar[XB_XCNT(j)]); sum += c; cnt += (c > 0u) ? 1u : 0u; mine = (j == x) ? c : mine; }
        if (sum == G) break;
        __builtin_amdgcn_s_sleep(1);
        if ((++sp & 255u) == 0u) { if (xb_ld(&bar[XB_TMO])) break; if (sp > XB_SPIN_CAP) { atomicAdd(&bar[XB_TMO], 1u); break; } }
    }
    nloc = mine > 0u ? mine : 1u; nx = cnt > 0u ? cnt : 1u;
}

__device__ __forceinline__ void xcd_barrier(const XcdBarrier& b, bool is_t0) {
    asm volatile("s_waitcnt vmcnt(0)" ::: "memory");
    __syncthreads();
    if (is_t0) {
        unsigned* bar = b.bar;
        __builtin_amdgcn_s_waitcnt(0);
        unsigned nloc = b.st[0], nx = b.st[1];
        if (nloc == 0u) { xcd_barrier_complete(bar, b.x, nloc, nx); b.st[0] = nloc; b.st[1] = nx; }
        const unsigned old = xb_add(&bar[XB_XSUB(b.x)], 1u);
        const unsigned gen = old / nloc;
        if (old + 1u == (gen + 1u) * nloc) {
            __builtin_amdgcn_fence(__ATOMIC_RELEASE, "agent");
            asm volatile("s_waitcnt vmcnt(0)" ::: "memory");
            const unsigned og = xb_add(&bar[XB_TOP], 1u);
            const unsigned tg = og / nx;
            if (og + 1u == (tg + 1u) * nx) xb_add(&bar[XB_TOPGEN], 1u);
            else XB_SPIN(xb_ld(&bar[XB_TOPGEN]) == tg, bar);
            __builtin_amdgcn_fence(__ATOMIC_ACQUIRE, "agent");
            xb_add(&bar[XB_XGEN(b.x)], 1u);
            asm volatile("s_waitcnt vmcnt(0)" ::: "memory");
        } else {
            XB_SPIN(xb_ld(&bar[XB_XGEN(b.x)]) == gen, bar);
            __builtin_amdgcn_fence(__ATOMIC_ACQUIRE, "agent");
            asm volatile("s_waitcnt vmcnt(0)" ::: "memory");
        }
    }
    __syncthreads();
}

static_assert(XCD_BAR_WORDS * 4 <= 16384, "barrier words");
using pg8::f32x4; using pg8::bf16_t; using pg8::bf16x8;

struct Params { const float* in[20]; float* out; unsigned char* ws; int ph_lo, ph_hi; };
enum { I_X = 0, I_C, I_CTX, I_CCTX, I_WADA, I_BADA, I_GATTN, I_WIN, I_QNA, I_KNA, I_QNB, I_KNB, I_RPB, I_SINK, I_CONVC, I_WO, I_GFFN, I_WUP, I_CONVF, I_WDOWN };

DI int ltid(int wv) { int lane; asm volatile("v_mbcnt_lo_u32_b32 %0, -1, 0\n\tv_mbcnt_hi_u32_b32 %0, -1, %0" : "=v"(lane)); return wv * 64 + lane; }
DI float wave_sum(float v, int lane) {
#pragma unroll
    for (int o = 32; o >= 1; o >>= 1) v += shx(v, o, lane);
    return v;
}

DI int win_src_col(int n) {
    if (n < 1280) { const int pn = n >> 8, cs = n & 255, bj = cs >> 7, wc = (cs & 127) >> 5, w = cs & 31, Hh = 4 * pn + wc;
        const int hc = Hh < 6 ? 64 * Hh : (Hh < 12 ? 384 + 64 * (Hh - 6) : (Hh < 18 ? 1152 + 64 * (Hh - 12) : 1536 + 64 * (Hh - 18)));
        return hc + 32 * bj + w; }
    if (n < 2048) return 1792 + (n - 1280);
    const int v = n - 2048; return v < 384 ? 768 + v : 1664 + (v - 384);
}
constexpr float LOG2E_ = 1.4426950408889634f;
DI int perm8_col(int n) { const int w = n & 31; return (n & ~31) + 8 * ((w >> 2) & 3) + 4 * (w >> 4) + (w & 3); }
DI int wup_src_col(int n) {
    const int pn = n >> 8, cs = n & 255, bj = cs >> 7, j = cs & 127, wc = j >> 5, n_ = (j >> 4) & 1, fq = (j >> 2) & 3, e = j & 3;
    return bj * DFF + 128 * pn + 32 * wc + 8 * fq + 4 * n_ + e;
}
struct TtTile { const float* src; bf16_t* dst; int which, K, srcN, n0, k0; };
DI TtTile tt_decode(const Params& p, unsigned char* ws, int t) {
    TtTile d; const int l = t / 3008; int r = t % 3008; int tn, tk;
    if (r < 640) { d.which = 0; tn = r >> 4; tk = r & 15; d.K = 1024; d.srcN = INW; }
    else if (r < 896) { r -= 640; d.which = 1; tn = r >> 4; tk = r & 15; d.K = 1024; d.srcN = DM; }
    else if (r < 2304) { r -= 896; d.which = 2; tn = r >> 4; tk = r & 15; d.K = 1024; d.srcN = UPW; }
    else { r -= 2304; d.which = 3; tn = r / 44; tk = r % 44; d.K = DFF; d.srcN = DM; }
    d.src = d.which == 0 ? p.in[I_WIN] + (size_t)l * DM * INW : (d.which == 1 ? p.in[I_WO] + (size_t)l * DM * DM : (d.which == 2 ? p.in[I_WUP] + (size_t)l * DM * UPW : p.in[I_WDOWN] + (size_t)l * DFF * DM));
    d.dst = (bf16_t*)(ws + (d.which == 0 ? WS_WIN + l * SZ_WIN : (d.which == 1 ? WS_WO + l * SZ_WO : (d.which == 2 ? WS_WUP + l * SZ_WUP : WS_WD + l * SZ_WD))));
    d.n0 = tn * 64; d.k0 = tk * 64; return d;
}
DI void tt_load(float (&v)[8], const TtTile& d, int tid) {
    const int n4 = tid & 15, kb = tid >> 4; const int nd = d.n0 + 4 * n4; const int sc = d.which == 0 ? win_src_col(nd) : (d.which == 2 ? wup_src_col(nd) : perm8_col(nd));
#pragma unroll
    for (int i = 0; i < 2; ++i) { const f32x4 x = *(const f32x4*)(d.src + (size_t)(d.k0 + kb + 32 * i) * d.srcN + sc); v[4 * i] = x[0]; v[4 * i + 1] = x[1]; v[4 * i + 2] = x[2]; v[4 * i + 3] = x[3]; }
}
DI void transpose_tiles(const Params& p, int wvs, float* sm, int t_begin, int t_end, int rank, int nranks) {
    const int tid = ltid(wvs); unsigned char* ws = p.ws;
    int t = t_begin + rank; if (t >= t_end) return;
    TtTile d = tt_decode(p, ws, t); float cur[8]; tt_load(cur, d, tid);
#pragma unroll 1
    for (;;) {
        const int t2 = t + nranks; const bool has = t2 < t_end;
        const TtTile d2 = tt_decode(p, ws, has ? t2 : t); float nxt[8];
        if (has) tt_load(nxt, d2, tid);
        { const int n4 = tid & 15, kb = tid >> 4;
#pragma unroll
          for (int i = 0; i < 2; ++i)
#pragma unroll
              for (int e = 0; e < 4; ++e) sm[(kb + 32 * i) * 65 + 4 * n4 + e] = cur[4 * i + e]; }
        __syncthreads();
        { const int n = tid >> 3, kg = tid & 7; float v[8];
#pragma unroll
          for (int j = 0; j < 8; ++j) v[j] = sm[(8 * kg + j) * 65 + n];
          u32x4 o; o[0] = pk2(v[0], v[1]); o[1] = pk2(v[2], v[3]); o[2] = pk2(v[4], v[5]); o[3] = pk2(v[6], v[7]);
          *(u32x4*)(d.dst + (size_t)(d.n0 + n) * d.K + d.k0 + 8 * kg) = o; }
        __syncthreads();
        if (!has) break;
        t = t2; d = d2;
#pragma unroll
        for (int i = 0; i < 8; ++i) cur[i] = nxt[i];
    }
}
DI void phase_prep(const Params& p, int wvs, float* sm) {
    const int tid = ltid(wvs); unsigned char* ws = p.ws;
    if (blockIdx.x == gridDim.x - 1) {
        float* rc = (float*)(ws + WS_ROPE); float* rs = rc + 1024;
        for (int e = tid; e < 1024; e += 512) { const int pos = e >> 4, f = e & 15;
            float invf = 1.0f;
#define IV(i, v) invf = (f == (i)) ? (v) : invf
            IV(1, 0.5623413324356079f); IV(2, 0.3162277638912201f); IV(3, 0.17782793939113617f); IV(4, 0.10000000149011612f); IV(5, 0.05623413249850273f); IV(6, 0.03162277489900589f); IV(7, 0.017782794311642647f);
            IV(8, 0.009999999776482582f); IV(9, 0.005623413249850273f); IV(10, 0.003162277629598975f); IV(11, 0.0017782794311642647f); IV(12, 0.0010000000474974513f); IV(13, 0.000562341301701963f); IV(14, 0.0003162277571391314f); IV(15, 0.00017782794020604342f);
#undef IV
            const float ang = (float)pos * invf; const double x = (double)ang;
            const double n = rint(x * 0.15915494309189535); const double r = x - n * 6.283185307179586476925; const double r2 = r * r;
            double c = 1.0, s = r, tc = 1.0, tsn = r;
#pragma unroll 1
            for (int i = 1; i <= 15; ++i) { tc *= -r2 / (double)((2 * i - 1) * (2 * i)); c += tc; tsn *= -r2 / (double)((2 * i) * (2 * i + 1)); s += tsn; }
            rc[e] = (float)c; rs[e] = (float)s; }
        { float* ng = (float*)(ws + WS_NG); const int l = tid >> 8, w = (tid >> 6) & 3, d = tid & 63;
          const float* s0 = w == 0 ? p.in[I_QNA] : (w == 1 ? p.in[I_KNA] : (w == 2 ? p.in[I_QNB] : p.in[I_KNB])); ng[tid] = s0[l * 64 + d]; }
        for (int l = 0; l < 2; ++l) {
            if (tid < 64) { sm[tid * 8 + 0] = fabsf(p.in[I_QNA][l * 64 + tid]); sm[tid * 8 + 1] = fabsf(p.in[I_KNA][l * 64 + tid]); sm[tid * 8 + 2] = fabsf(p.in[I_QNB][l * 64 + tid]); sm[tid * 8 + 3] = fabsf(p.in[I_KNB][l * 64 + tid]);
                sm[tid * 8 + 5] = tid < 6 ? p.in[I_SINK][l * 6 + tid] : -1e30f; }
            { float bm = 0.f;
#pragma unroll
              for (int k = 0; k < 6; ++k) { const int i = tid + 512 * k; bm = fmaxf(bm, i < 6 * 15 * 31 ? p.in[I_RPB][l * 2790 + i] : 0.f); }
              sm[512 + tid] = bm; }
            __syncthreads();
            if (tid < 64) { float bm = 0.f;
#pragma unroll
              for (int k = 0; k < 8; ++k) bm = fmaxf(bm, sm[512 + tid + 64 * k]);
              sm[tid * 8 + 4] = bm; }
            __syncthreads();
            if (tid == 0) { float g0 = 0.f, g1 = 0.f, g2 = 0.f, g3 = 0.f, bm = 0.f, sk = -1e30f;
                for (int i = 0; i < 64; ++i) { g0 = fmaxf(g0, sm[i * 8]); g1 = fmaxf(g1, sm[i * 8 + 1]); g2 = fmaxf(g2, sm[i * 8 + 2]); g3 = fmaxf(g3, sm[i * 8 + 3]); bm = fmaxf(bm, sm[i * 8 + 4]); sk = fmaxf(sk, sm[i * 8 + 5]); }
                const float qk = 0.125f * 64.0f * LOG2E_ * 1.01f; float* sm2 = (float*)(ws + WS_SM);
                sm2[l * 2 + 0] = qk * g0 * g1 + LOG2E_ * bm; sm2[l * 2 + 1] = fmaxf(qk * g2 * g3, LOG2E_ * sk); }
            __syncthreads();
        }
    }
    {
        float* scv = sm; float* red = sm + 9 * 1024;
        bool loaded = false;
        for (int it = blockIdx.x; it < 192; it += gridDim.x) {
            if (!loaded) { float cv[18];
#pragma unroll
                for (int k = 0; k < 18; ++k) { const int i = tid + 512 * k; cv[k] = i < 8192 ? p.in[I_C][i] : p.in[I_CCTX][i - 8192]; }
#pragma unroll
                for (int k = 0; k < 18; ++k) scv[tid + 512 * k] = cv[k] / (1.0f + __expf(-cv[k]));
                loaded = true; __syncthreads(); }
            const int l = it / 96, j0 = (it % 96) * 64, tx = tid & 15, ty = tid >> 4;
            f32x4 a[9];
#pragma unroll
            for (int b = 0; b < 9; ++b) a[b] = (f32x4){0.f, 0.f, 0.f, 0.f};
            const float* wp = p.in[I_WADA] + (size_t)l * DM * MODW + j0 + 4 * tx;
#pragma unroll 16
            for (int i = 0; i < 32; ++i) { const int k = ty + 32 * i; const f32x4 w4 = *(const f32x4*)(wp + (size_t)k * MODW);
#pragma unroll
                for (int b = 0; b < 9; ++b) a[b] += w4 * scv[b * 1024 + k]; }
#pragma unroll
            for (int b = 0; b < 9; ++b) *(f32x4*)(red + (ty * 9 + b) * 64 + 4 * tx) = a[b];
            __syncthreads();
            for (int o = tid; o < 576; o += 512) { const int b = o >> 6, ci = o & 63; float s = 0.f;
                for (int y = 0; y < 32; ++y) s += red[(y * 9 + b) * 64 + ci];
                ((float*)(ws + WS_MOD))[(size_t)(l * 9 + b) * MODW + j0 + ci] = s + p.in[I_BADA][l * MODW + j0 + ci]; }
            __syncthreads();
        }
        __syncthreads();
    }
}

struct PnSrc { const float* latf; const bf16_t* latb; const float* ctxf; const bf16_t* ctxb; const bf16_t* parts; int nparts; bf16_t* rc_out; bf16_t* lat_out; };
DI void pn_load(f32x4 (&v)[4], const PnSrc& S, int row, int lane) {
    const bool isl = row < ML; const size_t ro = (size_t)(isl ? row : row - ML) * DM + 8 * lane;
    const float* sf = isl ? S.latf : S.ctxf; const bf16_t* sb = isl ? S.latb : S.ctxb;
    if (sb) {
#pragma unroll
        for (int c = 0; c < 2; ++c) { const u32x4 rb = *(const u32x4*)(sb + ro + 512 * c);
            v[2 * c][0] = bflo(rb[0]); v[2 * c][1] = bfhi(rb[0]); v[2 * c][2] = bflo(rb[1]); v[2 * c][3] = bfhi(rb[1]); v[2 * c + 1][0] = bflo(rb[2]); v[2 * c + 1][1] = bfhi(rb[2]); v[2 * c + 1][2] = bflo(rb[3]); v[2 * c + 1][3] = bfhi(rb[3]); }
    } else {
#pragma unroll
        for (int i = 0; i < 4; ++i) v[i] = *(const f32x4*)(sf + ro + (i >> 1) * 512 + 4 * (i & 1));
    }
}
DI void pn_finish(f32x4 (&v)[4], const PnSrc& S, int row, int lane, const f32x4 (&g4)[4], const float* modl, int shoff, int scoff, bf16_t* H) {
    const bool isl = row < ML; const size_t ro = (size_t)(isl ? row : row - ML) * DM + 8 * lane; const int b = isl ? (row >> 12) : 8;
    if (!isl && S.nparts > 0) {
        const bf16_t* pr = S.parts + ro;
#pragma unroll 1
        for (int s = 0; s < S.nparts; ++s) {
#pragma unroll
            for (int c = 0; c < 2; ++c) { const u32x4 rb = *(const u32x4*)(pr + (size_t)s * MC * DM + 512 * c);
                v[2 * c][0] += bflo(rb[0]); v[2 * c][1] += bfhi(rb[0]); v[2 * c][2] += bflo(rb[1]); v[2 * c][3] += bfhi(rb[1]); v[2 * c + 1][0] += bflo(rb[2]); v[2 * c + 1][1] += bfhi(rb[2]); v[2 * c + 1][2] += bflo(rb[3]); v[2 * c + 1][3] += bfhi(rb[3]); } }
        if (S.rc_out) {
#pragma unroll
            for (int c = 0; c < 2; ++c) { u32x4 ob; ob[0] = pk2(v[2 * c][0], v[2 * c][1]); ob[1] = pk2(v[2 * c][2], v[2 * c][3]); ob[2] = pk2(v[2 * c + 1][0], v[2 * c + 1][1]); ob[3] = pk2(v[2 * c + 1][2], v[2 * c + 1][3]);
                *(u32x4*)(S.rc_out + ro + 512 * c) = ob; } }
    }
    if (isl && S.lat_out) {
#pragma unroll
        for (int c = 0; c < 2; ++c) { u32x4 ob; ob[0] = pk2(v[2 * c][0], v[2 * c][1]); ob[1] = pk2(v[2 * c][2], v[2 * c][3]); ob[2] = pk2(v[2 * c + 1][0], v[2 * c + 1][1]); ob[3] = pk2(v[2 * c + 1][2], v[2 * c + 1][3]);
            *(u32x4*)(S.lat_out + ro + 512 * c) = ob; } }
    float ss = 0.f;
#pragma unroll
    for (int i = 0; i < 4; ++i) ss += v[i][0] * v[i][0] + v[i][1] * v[i][1] + v[i][2] * v[i][2] + v[i][3] * v[i][3];
    ss = wave_sum(ss, lane); const float rstd = rsqrtf(ss * (1.0f / 1024.0f) + EPSN);
    const float* mb = modl + (size_t)b * MODW;
    f32x4 y[4];
#pragma unroll
    for (int i = 0; i < 4; ++i) { const int col = (i >> 1) * 512 + 8 * lane + 4 * (i & 1); const f32x4 sc4 = *(const f32x4*)(mb + scoff + col), sh4 = *(const f32x4*)(mb + shoff + col);
        y[i] = v[i] * rstd * g4[i] * (sc4 + 1.0f) + sh4; }
#pragma unroll
    for (int c = 0; c < 2; ++c) { u32x4 o; o[0] = pk2(y[2 * c][0], y[2 * c][1]); o[1] = pk2(y[2 * c][2], y[2 * c][3]); o[2] = pk2(y[2 * c + 1][0], y[2 * c + 1][1]); o[3] = pk2(y[2 * c + 1][2], y[2 * c + 1][3]);
        *(u32x4*)(H + (size_t)row * DM + 512 * c + 8 * lane) = o; }
}
DI void phase_prenorm(int wvs, const float* latf, const bf16_t* latb, const float* ctxf, const bf16_t* ctxb, const float* g, const float* modl, int shoff, int scoff, bf16_t* H, int nrows, const bf16_t* parts, int nparts, bf16_t* rc_out, bf16_t* lat_out) {
    const int tid = ltid(wvs); const int lane = tid & 63, gw = blockIdx.x * 8 + __builtin_amdgcn_readfirstlane(tid >> 6), nw = gridDim.x * 8;
    const PnSrc S{latf, latb, ctxf, ctxb, parts, nparts, rc_out, lat_out};
    f32x4 g4[4];
#pragma unroll
    for (int i = 0; i < 4; ++i) g4[i] = *(const f32x4*)(g + (i >> 1) * 512 + 8 * lane + 4 * (i & 1));
    for (int row = gw; row < nrows; row += 2 * nw) {
        const int row2 = row + nw; const bool has2 = row2 < nrows;
        f32x4 va[4], vb[4];
        pn_load(va, S, row, lane);
        if (has2) pn_load(vb, S, row2, lane);
        pn_finish(va, S, row, lane, g4, modl, shoff, scoff, H);
        if (has2) pn_finish(vb, S, row2, lane, g4, modl, shoff, scoff, H);
    }
}

DI void unpack8(const u32x4 u, float (&f)[8]) {
#pragma unroll
    for (int i = 0; i < 4; ++i) { f[2 * i] = bflo(u[i]); f[2 * i + 1] = bfhi(u[i]); }
}
DI void phase_fixup(int wvs, const bf16_t* UPB, bf16_t* ACT, const float* cw  , int nrows) {
    const int tid = ltid(wvs);
    const int total = (nrows >> 6) * 2 * 352; const int stride = gridDim.x * 512;
    for (int i = blockIdx.x * 512 + tid; i < total; i += stride) {
        const int cg8 = i % 352, j = i / 352, side = j & 1, blk = j >> 1, c = cg8 * 8; const int row = blk * 64 + (side ? 63 : 0);
        int t, L; if (row < ML) { t = row & (SEQL - 1); L = SEQL; } else { t = (row - ML) & (CTXL - 1); L = CTXL; }
        const bf16_t* rp[3];
        rp[1] = UPB + ((size_t)blk * 4 + (side ? 3 : 0)) * UPW + c;
        rp[0] = side ? UPB + ((size_t)blk * 4 + 2) * UPW + c : UPB + ((size_t)(blk - 1) * 4 + 3) * UPW + c;
        rp[2] = side ? UPB + ((size_t)(blk + 1) * 4 + 0) * UPW + c : UPB + ((size_t)blk * 4 + 1) * UPW + c;
        float a[8], g[8];
#pragma unroll
        for (int q = 0; q < 8; ++q) { a[q] = 0.f; g[q] = 0.f; }
#pragma unroll
        for (int k = 0; k < 3; ++k) {
            if ((k == 0 && t == 0) || (k == 2 && t == L - 1)) continue;
            float ua[8], ug[8]; unpack8(*(const u32x4*)rp[k], ua); unpack8(*(const u32x4*)(rp[k] + DFF), ug);
            const f32x4 wa0 = *(const f32x4*)(cw + k * UPW + c), wa1 = *(const f32x4*)(cw + k * UPW + c + 4), wg0 = *(const f32x4*)(cw + k * UPW + DFF + c), wg1 = *(const f32x4*)(cw + k * UPW + DFF + c + 4);
#pragma unroll
            for (int q = 0; q < 4; ++q) { a[q] += ua[q] * wa0[q]; a[4 + q] += ua[4 + q] * wa1[q]; g[q] += ug[q] * wg0[q]; g[4 + q] += ug[4 + q] * wg1[q]; }
        }
        float o[8];
#pragma unroll
        for (int q = 0; q < 8; ++q) o[q] = a[q] / (1.0f + __expf(-a[q])) * g[q];
        u32x4 ov; ov[0] = pk2(o[0], o[1]); ov[1] = pk2(o[2], o[3]); ov[2] = pk2(o[4], o[5]); ov[3] = pk2(o[6], o[7]);
        *(u32x4*)(ACT + (size_t)row * DFF + c) = ov;
    }
}

#define MFMA32(a, b, c) __builtin_amdgcn_mfma_f32_32x32x16_bf16((a), (b), (c), 0, 0, 0)
constexpr int RPB_PITCH = 80, RPB_SHIFT = 24;
constexpr float LOG2E = 1.4426950408889634f;
struct AttnAcc { f32x16 o0, o1; float l; };
struct TileLd { bf16x8 k[4]; bf16x8 v[4]; };
struct MBNone { float negM; DI float operator()(int, float s) const { return s + negM; } };
template <int REM> struct MBGen {
    const float* bl; int v0; unsigned width;
    DI float operator()(int r, float s) const {
        const int off = REM ? (r & 7) : 16 * (r >> 3) + (r & 7);
        const float bias = bl[REM ? (2 * (r >> 3)) * RPB_PITCH + (r & 7) : off];
        return ((unsigned)(off - v0) < width) ? s + bias : -1e30f;
    }
};
DI void tile_load(TileLd& L, const bf16_t* kp, const bf16_t* vA, const bf16_t* vB) {
#pragma unroll
    for (int kk = 0; kk < 4; ++kk) L.k[kk] = *(const bf16x8*)(kp + 128 * kk);
    L.v[0] = *(const bf16x8*)vA; L.v[1] = *(const bf16x8*)vB; L.v[2] = *(const bf16x8*)(vA + 256); L.v[3] = *(const bf16x8*)(vB + 256);
}
DI f32x16 tile_qk(const bf16x8 (&qf)[4], const TileLd& L) {
    f32x16 s;
#pragma unroll
    for (int r = 0; r < 16; ++r) s[r] = 0.f;
#pragma unroll
    for (int kk = 0; kk < 4; ++kk) s = MFMA32(L.k[kk], qf[kk], s);
    return s;
}
typedef __attribute__((address_space(3))) unsigned char lds_u8;
DI void tile_load_lds(TileLd& L, const lds_u8* kp, const lds_u8* vA) {
#pragma unroll
    for (int kk = 0; kk < 4; ++kk) L.k[kk] = *(const __attribute__((address_space(3))) bf16x8*)(kp + 256 * kk);
    L.v[0] = *(const __attribute__((address_space(3))) bf16x8*)vA; L.v[1] = *(const __attribute__((address_space(3))) bf16x8*)(vA + 2048);
    L.v[2] = *(const __attribute__((address_space(3))) bf16x8*)(vA + 512); L.v[3] = *(const __attribute__((address_space(3))) bf16x8*)(vA + 2048 + 512);
}
template <class MB> DI void tile_rest(AttnAcc& a, f32x16 s, const TileLd& L, const MB& mb) {
    float ls = 0.f;
#pragma unroll
    for (int r = 0; r < 16; ++r) { const float pv = __builtin_amdgcn_exp2f(mb(r, s[r])); ls += pv; s[r] = pv; }
    a.l += ls;
    u32x4 p0, p1;
#pragma unroll
    for (int j = 0; j < 4; ++j) { p0[j] = pk2(s[2 * j], s[2 * j + 1]); p1[j] = pk2(s[8 + 2 * j], s[8 + 2 * j + 1]); }
    const bf16x8 pb0 = __builtin_bit_cast(bf16x8, p0), pb1 = __builtin_bit_cast(bf16x8, p1);
    a.o0 = MFMA32(L.v[0], pb0, a.o0); a.o0 = MFMA32(L.v[1], pb1, a.o0);
    a.o1 = MFMA32(L.v[2], pb0, a.o1); a.o1 = MFMA32(L.v[3], pb1, a.o1);
}

template <int probe> DI void attn_item(int lane, int type, int idx, const bf16_t* QK, const bf16_t* KB, const bf16_t* VT, bf16_t* Y, const float* tab, const float* sink, const float* shifts, const lds_u8* limg) {
    const int q = lane & 31, h = lane >> 5;
    const int pi = 16 * (q >> 4) + 8 * ((q >> 2) & 1) + 4 * ((q >> 3) & 1) + (q & 3);
    int head, b, qrow, Hq, Hk, vrow0, ocol; bool has_sink;
    int jj = 0, rq = 0, t0 = 0, nt = 8, m_lo = 0;
    if (type == 0) { head = idx % 6; int t = idx / 6; jj = t & 1; t >>= 1; rq = t & 63; b = t >> 6; qrow = b * SEQL + rq * 64 + 32 * jj + q; Hq = head; Hk = 6 + head; vrow0 = 64 * head; ocol = 64 * head; has_sink = false; nt = 18; }
    else if (type == 1) { head = idx % 6; int t = idx / 6; const int qb = t & 127; b = t >> 7; t0 = qb * 32; qrow = b * SEQL + t0 + q; Hq = 12 + head; Hk = 18 + head / 3; vrow0 = 384 + 64 * (head / 3); ocol = 384 + 64 * head; has_sink = true;
        m_lo = t0 < 128 ? (128 - t0) >> 5 : 0; const int m_hi = min(8, (4192 - t0) >> 5); nt = 8 + m_hi - m_lo + 1; }
    else { head = idx % 6; int t = idx / 6; const int qb = t & 7; b = t >> 3; qrow = ML + b * CTXL + qb * 32 + q;
        if (type == 2) { Hq = head; Hk = 6 + head; vrow0 = 64 * head; ocol = 64 * head; has_sink = false; }
        else { Hq = 12 + head; Hk = 18 + head / 3; vrow0 = 384 + 64 * (head / 3); ocol = 384 + 64 * head; has_sink = true; } }
    if (probe & 2) nt = 2;
    bf16x8 qf[4];
    { const bf16_t* qp = QK + ((size_t)qrow * 20 + Hq) * 64 + 8 * h;
#pragma unroll
      for (int kk = 0; kk < 4; ++kk) qf[kk] = *(const bf16x8*)(qp + 16 * kk); }
    AttnAcc a;
#pragma unroll
    for (int r = 0; r < 16; ++r) { a.o0[r] = 0.f; a.o1[r] = 0.f; }
    const float negM = -shifts[(type & 1)];
    a.l = (has_sink && h == 0) ? __builtin_amdgcn_exp2f(sink[head] * LOG2E + negM) : 0.f;
    const int kvhead = Hk < 12 ? Hk - 6 : Hk - 12;
    const bf16_t* Kh = KB + (size_t)kvhead * (MT / 8) * 512 + 64 * h;
    const bf16_t* Vd = VT + ((size_t)kvhead * (MT / 8) * 64 + q) * 8;
    (void)vrow0;
    const int cq = 32 * jj + q; const int r0 = min(max(rq - 4, 0), 56), c0 = min(max(cq - 8, 0), 48);
    const float* th = tab + (size_t)head * 15 * RPB_PITCH + RPB_SHIFT;
    const int cb = ML + b * CTXL, lb = b * SEQL;
    const int ko_lin = pi, ko_rem = (pi >> 3) * 64 + (pi & 7);
    const lds_u8* lk = limg + (pi >> 3) * 1024 + ((((pi & 7) * 16) + 128 * h) ^ (((pi >> 3) & 1) << 7));
    const lds_u8* lv = limg + 32768 + h * 1024 + q * 16;
#define TILE_INFO(t, tb, mode, aux) int tb, mode, aux; { const int t_ = (t); \
        if (t_ < 8) { tb = cb + 32 * t_; mode = 0; aux = 0; } \
        else if (type == 0) { const int i_ = t_ - 8; if (i_ < 8) { tb = lb + (r0 + i_) * 64 + 24 * jj; mode = 1; aux = i_; } else { tb = lb + (r0 + 4 * (i_ - 8)) * 64 + 24 * jj + 32; mode = 2; aux = i_ - 8; } } \
        else { const int m_ = m_lo + t_ - 8; tb = lb + t0 - 128 + 32 * m_; mode = m_ == 0 ? 3 : (m_ == 8 ? 4 : 0); aux = 0; } }
#define TILE_LOAD(L, t) do { TILE_INFO(t, tb_, md_, ax_); (void)ax_; if ((t) < 8) tile_load_lds(L, lk + 4096 * (t), lv + 4096 * (t)); else { const bool rem_ = md_ == 2; const int kt_ = tb_ + (rem_ ? ko_rem : ko_lin); const int g8_ = tb_ >> 3; \
        tile_load(L, Kh + (size_t)(kt_ >> 3) * 512 + (kt_ & 7) * 8, Vd + (size_t)(g8_ + (rem_ ? 8 * h : h)) * 512, Vd + (size_t)(g8_ + (rem_ ? 8 * (2 + h) : 2 + h)) * 512); } } while (0)
#define TILE_COMP(L, t, s_) do { TILE_INFO(t, tb_, md_, ax_); (void)tb_; \
        if (md_ == 0) tile_rest(a, s_, L, MBNone{negM}); \
        else if (md_ == 2) tile_rest(a, s_, L, MBGen<1>{th + (r0 + 4 * ax_ - rq + 7 + h) * RPB_PITCH + (47 - 8 * jj - q), c0 - 24 * jj - 32, 16u}); \
        else { MBGen<0> mb_; if (md_ == 1) { mb_.bl = th + (r0 + ax_ - rq + 7) * RPB_PITCH + (8 * h + 15 - 8 * jj - q); mb_.v0 = c0 - 24 * jj - 8 * h; mb_.width = 16u; } \
               else { mb_.bl = tab + 90 * RPB_PITCH; mb_.v0 = md_ == 3 ? q - 8 * h : q - 8 * h - 1000; mb_.width = md_ == 3 ? 0x7fffffffu : 1001u; } \
               tile_rest(a, s_, L, mb_); } } while (0)
#define ATT_STEP(LA, LC) { if (t >= nt) break; const f32x16 sq_ = tile_qk(qf, LA); __builtin_amdgcn_sched_barrier(0); if (!(probe & 1)) TILE_LOAD(LC, min(t + 2, nt - 1)); __builtin_amdgcn_sched_barrier(0); TILE_COMP(LA, t, sq_); ++t; }
    TileLd L0, L1, L2;
    TILE_LOAD(L0, 0); TILE_LOAD(L1, 1);
    int t = 0;
#pragma unroll 1
    for (;;) { ATT_STEP(L0, L2) ATT_STEP(L1, L0) ATT_STEP(L2, L1) }
#undef ATT_STEP
#undef TILE_COMP
#undef TILE_LOAD
#undef TILE_INFO
    const float lt = a.l + shx(a.l, 32, lane); const float inv = 1.0f / lt;
    bf16_t* yp = Y + (size_t)qrow * DM + ocol + 4 * h;
#pragma unroll
    for (int g = 0; g < 4; ++g) { u32x2 o0, o1;
        o0[0] = pk2(a.o0[4 * g] * inv, a.o0[4 * g + 1] * inv); o0[1] = pk2(a.o0[4 * g + 2] * inv, a.o0[4 * g + 3] * inv);
        o1[0] = pk2(a.o1[4 * g] * inv, a.o1[4 * g + 1] * inv); o1[1] = pk2(a.o1[4 * g + 2] * inv, a.o1[4 * g + 3] * inv);
        *(u32x2*)(yp + 8 * g) = o0; *(u32x2*)(yp + 32 + 8 * g) = o1; }
}
DI void sconv_item(int lane, int row0, const bf16_t* UBC, bf16_t* Y, const float* cw  ) {
    const int c = (lane & 31) * 8;
    f32x4 w[3][2];
#pragma unroll
    for (int k = 0; k < 3; ++k) { w[k][0] = *(const f32x4*)(cw + k * 256 + c); w[k][1] = *(const f32x4*)(cw + k * 256 + c + 4); }
#pragma unroll
    for (int it = 0; it < 4; ++it) {
        const int row = row0 + it * 2 + (lane >> 5);
        int t, L; if (row < ML) { t = row & (SEQL - 1); L = SEQL; } else { t = (row - ML) & (CTXL - 1); L = CTXL; }
        float acc[8];
#pragma unroll
        for (int j = 0; j < 8; ++j) acc[j] = 0.f;
#pragma unroll
        for (int k = 0; k < 3; ++k) {
            if ((k == 0 && t == 0) || (k == 2 && t == L - 1)) continue;
            const bf16_t* rp = UBC + (size_t)(row + k - 1) * UBCW + c; float u[8], cgv[8]; unpack8(*(const u32x4*)rp, u); unpack8(*(const u32x4*)(rp + 512), cgv);
#pragma unroll
            for (int j = 0; j < 8; ++j) acc[j] += (cgv[j] * u[j]) * w[k][j >> 2][j & 3];
        }
        float bg[8]; unpack8(*(const u32x4*)(UBC + (size_t)row * UBCW + 256 + c), bg);
        u32x4 o;
#pragma unroll
        for (int j = 0; j < 4; ++j) o[j] = pk2(bg[2 * j] * acc[2 * j], bg[2 * j + 1] * acc[2 * j + 1]);
        *(u32x4*)(Y + (size_t)row * DM + 768 + c) = o;
    }
}
template <int probe> DI void phase_mix(const Params& p, int wvs, int l, unsigned char* ldsraw) {
    float* tab = (float*)(ldsraw + LDS_TAB);
    const int tid = ltid(wvs); unsigned char* ws = p.ws;
    const float* rpb = p.in[I_RPB] + (size_t)l * 6 * 15 * 31; const float* shifts = (const float*)(ws + WS_SM) + l * 2;
    for (int i = tid; i < 91 * RPB_PITCH; i += 512) { const int ri = i / RPB_PITCH, dc = i % RPB_PITCH - RPB_SHIFT; tab[i] = (ri < 90 ? ((dc >= 0 && dc < 31) ? rpb[ri * 31 + dc] * LOG2E : 0.f) - shifts[0] : -shifts[1]); }
    __syncthreads();
    const bf16_t* QK = (const bf16_t*)(ws + WS_QK); const bf16_t* KB = (const bf16_t*)(ws + WS_KB); const bf16_t* VT = (const bf16_t*)(ws + WS_VT); const bf16_t* UBC = (const bf16_t*)(ws + WS_UBC); bf16_t* Y = (bf16_t*)(ws + (probe ? WS_PART : WS_Y));
    const float* sink = p.in[I_SINK] + l * 6; const float* cw = p.in[I_CONVC] + l * 3 * 256;
    const int wv = __builtin_amdgcn_readfirstlane(tid >> 6);
    const int b = blockIdx.x & 7, kb = blockIdx.x >> 3, nblk = ((int)gridDim.x - b + 7) >> 3;
    const int NAsz = l == 0 ? 136 : 128, WGsz = l == 0 ? 408 : 384, NAtot = 6 * NAsz, T = NAtot + 2 * WGsz;
    const int nNA = max(1, min(nblk - 1, (nblk * 17 + 16) / 32));
    const int I0 = kb < nNA ? kb * NAtot / nNA : NAtot + (kb - nNA) * (T - NAtot) / (nblk - nNA);
    const int I1 = kb < nNA ? (kb + 1) * NAtot / nNA : NAtot + (kb - nNA + 1) * (T - NAtot) / (nblk - nNA);
    const int sA = I0 < NAtot ? I0 / NAsz : 6 + (I0 - NAtot) / WGsz;
    lds_u8* img = (lds_u8*)(__attribute__((address_space(3))) unsigned char*)ldsraw;
    for (int si = 0; si < 2; ++si) { const int s = sA + si; if (s > 7) break;
        const size_t off = ((size_t)s * (MT / 8) + (ML + b * CTXL) / 8) * 512;
        const u32x4* ks = (const u32x4*)(KB + off); const u32x4* vs = (const u32x4*)(VT + off);
#pragma unroll
        for (int i = 0; i < 4; ++i) { const int pc = tid + 512 * i, grp = pc >> 6, j = pc & 63;
            *(__attribute__((address_space(3))) u32x4*)(img + si * 65536 + grp * 1024 + ((j * 16) ^ ((grp & 1) << 7))) = ks[pc];
            *(__attribute__((address_space(3))) u32x4*)(img + si * 65536 + 32768 + pc * 16) = vs[pc]; } }
    __syncthreads();
#pragma unroll 1
    for (int I = I0 + wv; I < I1; I += 8) {
        int type, idx, s;
        if (I < NAtot) { s = I / NAsz; const int w = I - s * NAsz;
            if (w < 128) { type = 0; idx = ((b * 64 + (w >> 1)) * 2 + (w & 1)) * 6 + s; } else { type = 2; idx = (b * 8 + (w - 128)) * 6 + s; } }
        else { const int J = I - NAtot, kv = J / WGsz, w = J - kv * WGsz; s = 6 + kv;
            if (w < 384) { type = 1; idx = (b * 128 + w / 3) * 6 + kv * 3 + w % 3; } else { const int w2 = w - 384; type = 3; idx = (b * 8 + w2 / 3) * 6 + kv * 3 + w2 % 3; } }
        attn_item<probe>(tid & 63, type, idx, QK, KB, VT, Y, tab, sink, shifts, img + (s - sA) * 65536);
    }
    if (!(probe & 4)) { const int lw = kb * 8 + wv, nlw = nblk * 8, n_sc = l == 0 ? 544 : 512;
#pragma unroll 1
      for (int k = lw; k < n_sc; k += nlw) sconv_item(tid & 63, k < 512 ? b * SEQL + 8 * k : ML + b * CTXL + 8 * (k - 512), UBC, Y, cw); }
}


constexpr int NPH = 17;
#ifndef MK_MULTI
#define MK_MULTI 0
#endif
#define GLOBAL_AS __attribute__((address_space(1)))
__global__ void __launch_bounds__(512, 2) mega_fwd(Params p_in) {
    Params p = p_in;
#pragma unroll
    for (int i = 0; i < 20; ++i) p.in[i] = (const float*)(GLOBAL_AS const float*)p_in.in[i];
    p.out = (float*)(GLOBAL_AS float*)p_in.out; p.ws = (unsigned char*)(GLOBAL_AS unsigned char*)p_in.ws;
    extern __shared__ __attribute__((aligned(16))) unsigned char lds[];
    cg::grid_group grid = cg::this_grid();
    const int G = gridDim.x, bx = blockIdx.x;
    const int wvs = __builtin_amdgcn_readfirstlane(threadIdx.x >> 6);
    PG8_LAS unsigned char* ldsl = (PG8_LAS unsigned char*)lds;
    volatile LAS unsigned* xst = (volatile LAS unsigned*)(ldsl + LDS_STAGE);
    if (threadIdx.x < 4) xst[threadIdx.x] = 0u;
    __syncthreads();
    XcdBarrier xbar; xbar.bar = (unsigned*)(p.ws + WS_BAR); xbar.x = 0; xbar.st = xst;
    if (p.ph_hi - p.ph_lo > 1) xbar = xcd_barrier_post((unsigned*)(p.ws + WS_BAR), xst);
#ifndef DUP_MASK
#define DUP_MASK 0
#endif
#define MIX_PROBE 2
#define DUP(c) for (int rep_ = 0; rep_ < (((DUP_MASK) >> (c)) & 1) + 1; ++rep_)
#define RUN(k) ((k) >= p.ph_lo && (k) < p.ph_hi)
#define SEAM(k) do { if ((k) + 1 < p.ph_hi) { if ((k) == 0 && p.ph_lo < 0) grid.sync(); xcd_barrier(xbar, ltid(wvs) == 0);     if ((DUP_MASK >> 8) & 1) xcd_barrier(xbar, ltid(wvs) == 0); } } while (0)
#define LAUNDER(ws, l) unsigned long long ws##_u = (unsigned long long)p.ws; int l = l0; asm volatile("" : "+s"(ws##_u), "+s"(l)); unsigned char* ws = (unsigned char*)(GLOBAL_AS unsigned char*)ws##_u
    if (RUN(0)) { DUP(0) { phase_prep(p, wvs, (float*)lds); __syncthreads(); } SEAM(0); }
#pragma unroll 1
    for (int l0 = 0; l0 < 2; ++l0) {
        const int pb = 1 + 8 * l0;
        if (RUN(pb + 0)) { LAUNDER(ws, l); DUP(1)
            phase_prenorm(wvs, p.in[I_X], l == 0 ? (const bf16_t*)nullptr : (const bf16_t*)(ws + WS_RB), p.in[I_CTX], l == 0 ? (const bf16_t*)nullptr : (const bf16_t*)(ws + WS_RB) + (size_t)ML * DM, p.in[I_GATTN] + l * DM, (const float*)(ws + WS_MOD) + (size_t)l * 9 * MODW, 0, DM, (bf16_t*)p.out, MT, (const bf16_t*)(ws + WS_PART), l == 0 ? 0 : 11, nullptr, l == 0 ? (bf16_t*)(ws + WS_RB) : (bf16_t*)nullptr);
            if (l == 0) { __syncthreads(); transpose_tiles(p, wvs, (float*)lds, 0, 3008, bx, G); }
            SEAM(pb + 0); }
        if (RUN(pb + 1)) { LAUNDER(ws, l);
            const bf16_t* H = (const bf16_t*)p.out; const bf16_t* WinT = (const bf16_t*)(ws + WS_WIN + l * SZ_WIN);
            PG8_LAS float* ropel = (PG8_LAS float*)(ldsl + LDS_TAB);
            { const int tid_ = ltid(wvs); const f32x4* rsrc = (const f32x4*)(ws + WS_ROPE); ((PG8_LAS f32x4*)ropel)[tid_] = rsrc[tid_]; }
            __syncthreads();
            DUP(2) {
              pg8::Gemm g{H, WinT, MT, 2048, DM, wvs}; pg8::TwoSegOrder S; S.init(MT, 2048, DM / 64, WinT + (size_t)2048 * DM, H, VTR, MT, 1, DM / 64, G, bx);
              pg8::EpiInProj E{(bf16_t*)(ws + WS_QK), (bf16_t*)(ws + WS_KB), (bf16_t*)(ws + WS_UBC), (bf16_t*)(ws + WS_VT), (const float*)(ws + WS_NG) + l * 256, ropel, ropel + 1024};
              pg8::gemm_phase<pg8::EpiInProj, pg8::TwoSegOrder, false>(ldsl, g, S, E, nullptr);
            }
            if (l == 0) { const int rem = (136 * 8 + 2 * 136) % G;
              if (rem == 0) transpose_tiles(p, wvs, (float*)lds, 3008, 6016, bx, G); else if (bx >= rem) transpose_tiles(p, wvs, (float*)lds, 3008, 6016, bx - rem, G - rem); }
            SEAM(pb + 1);
        }
        if (RUN(pb + 2)) { phase_mix<0>(p, wvs, l0, lds); __syncthreads();
            if ((DUP_MASK >> 3) & 1) { phase_mix<MIX_PROBE>(p, wvs, l0, lds); __syncthreads(); } SEAM(pb + 2); }
        if (RUN(pb + 3)) { LAUNDER(ws, l);
            const bf16_t* Yp = (const bf16_t*)(ws + WS_Y); const bf16_t* WoT = (const bf16_t*)(ws + WS_WO + l * SZ_WO);
            pg8::Gemm g{Yp, WoT, ML, DM, DM, wvs}; pg8::TwoSegOrder S; S.init(ML, DM, DM / 64, Yp + (size_t)ML * DM, WoT, l == 0 ? MC : 0, DM, 4, 4, G, bx);
            pg8::EpiResid E{(const void*)(ws + WS_RB), (void*)(ws + WS_RB), 1, 1, (bf16_t*)(ws + WS_PART), (const float*)(ws + WS_MOD) + (size_t)l * 9 * MODW + 2 * DM};
            pg8::gemm_phase<pg8::EpiResid, pg8::TwoSegOrder, false>(ldsl, g, S, E, nullptr);
            SEAM(pb + 3);
        }
        if (RUN(pb + 4)) { LAUNDER(ws, l); DUP(1)
            phase_prenorm(wvs, nullptr, (const bf16_t*)(ws + WS_RB), p.in[I_CTX], nullptr, p.in[I_GFFN] + l * DM, (const float*)(ws + WS_MOD) + (size_t)l * 9 * MODW, 3 * DM, 4 * DM, (bf16_t*)p.out, l == 0 ? MT : ML, (const bf16_t*)(ws + WS_PART), 4, (bf16_t*)(ws + WS_RB) + (size_t)ML * DM, nullptr); SEAM(pb + 4); }
        if (RUN(pb + 5)) { LAUNDER(ws, l);
            const int M = l == 0 ? MT : ML;
            pg8::Gemm g{(const bf16_t*)p.out, (const bf16_t*)(ws + WS_WUP + l * SZ_WUP), M, UPW, DM, wvs}; pg8::StaticOrder S; S.init(M, UPW, G, bx); S.ntk = DM / 64;
            pg8::EpiUpConv E{(bf16_t*)(ws + WS_ACT), (bf16_t*)(ws + WS_UPB), p.in[I_CONVF] + (size_t)l * 3 * UPW};
            DUP(5) pg8::gemm_phase<pg8::EpiUpConv, pg8::StaticOrder, false>(ldsl, g, S, E, nullptr);
            SEAM(pb + 5);
        }
        if (RUN(pb + 6)) { LAUNDER(ws, l); DUP(6) phase_fixup(wvs, (const bf16_t*)(ws + WS_UPB), (bf16_t*)(ws + WS_ACT), p.in[I_CONVF] + (size_t)l * 3 * UPW, l == 0 ? MT : ML); SEAM(pb + 6); }
        if (RUN(pb + 7)) { LAUNDER(ws, l);
            const bf16_t* ACTp = (const bf16_t*)(ws + WS_ACT); const bf16_t* WdT = (const bf16_t*)(ws + WS_WD + l * SZ_WD);
            pg8::Gemm g{ACTp, WdT, ML, DM, DFF, wvs}; pg8::TwoSegOrder S; S.init(ML, DM, DFF / 64, ACTp + (size_t)ML * DFF, WdT, l == 0 ? MC : 0, DM, 11, 4, G, bx);
            pg8::EpiResid E{(const void*)(ws + WS_RB), l == 0 ? (void*)(ws + WS_RB) : (void*)p.out, 1, l == 0 ? 1 : 0, (bf16_t*)(ws + WS_PART), (const float*)(ws + WS_MOD) + (size_t)l * 9 * MODW + 5 * DM};
            pg8::gemm_phase<pg8::EpiResid, pg8::TwoSegOrder, false>(ldsl, g, S, E, nullptr);
            SEAM(pb + 7);
        }
    }
}

extern "C" void kernel_launch(void* const* d_in, const int* in_sizes, int n_in, void* d_out, int out_size, void* d_ws, size_t ws_size, hipStream_t stream) {
    static int grid = 0;
    if (grid == 0) {
        if (n_in != 20 || out_size != ML * DM || ws_size < WS_END) { fprintf(stderr, "kernel_launch: unexpected shapes (n_in %d out %d ws %zu need %zu)\n", n_in, out_size, ws_size, (size_t)WS_END); grid = -1; return; }
        int dev = 0, cus = 0, per_cu = 0;
        (void)hipGetDevice(&dev); (void)hipDeviceGetAttribute(&cus, hipDeviceAttributeMultiprocessorCount, dev);
        if (hipFuncSetAttribute((const void*)mega_fwd, hipFuncAttributeMaxDynamicSharedMemorySize, LDS_BYTES) != hipSuccess) { fprintf(stderr, "kernel_launch: hipFuncSetAttribute failed\n"); grid = -1; return; }
        if (hipOccupancyMaxActiveBlocksPerMultiprocessor(&per_cu, (const void*)mega_fwd, 512, LDS_BYTES) != hipSuccess || per_cu < 1) { fprintf(stderr, "kernel_launch: occupancy query failed (%d)\n", per_cu); (void)hipGetLastError(); per_cu = 1; }
        grid = cus * per_cu;
        fprintf(stderr, "kernel_launch: grid %d (cus %d x %d)\n", grid, cus, per_cu);
        if (grid < 128 || (grid & 7)) { fprintf(stderr, "kernel_launch: the mixer phase's LDS context images need a grid of >= 128 workgroups, a multiple of 8 (got %d)\n", grid); grid = -1; return; }
    }
    if (grid < 0) return;
    if (hipMemsetAsync((char*)d_ws + WS_BAR, 0, WS_BAR_BYTES, stream) != hipSuccess) { fprintf(stderr, "kernel_launch: memset failed\n"); return; }
    Params p{};
    for (int i = 0; i < 20; ++i) p.in[i] = (const float*)d_in[i];
    p.out = (float*)d_out; p.ws = (unsigned char*)d_ws;
#if MK_MULTI
    for (int k = 0; k < NPH; ++k) { p.ph_lo = k; p.ph_hi = k + 1; hipLaunchKernelGGL(mega_fwd, dim3(grid), dim3(512), LDS_BYTES, stream, p); }
#else
    p.ph_lo = 0; p.ph_hi = NPH;
    void* args[] = {&p};
    hipError_t e = hipLaunchCooperativeKernel((const void*)mega_fwd, dim3(grid), dim3(512), args, LDS_BYTES, stream);
    if (e != hipSuccess) fprintf(stderr, "kernel_launch: cooperative launch failed: %s (grid %d)\n", hipGetErrorString(e), grid);
#endif
}
```

```cpp
#include <hip/hip_runtime.h>
#include <hip/hip_cooperative_groups.h>
#include <cstdio>
namespace cg = cooperative_groups;
#define DI __device__ __forceinline__
typedef float f32x16 __attribute__((ext_vector_type(16)));
typedef unsigned u32x2 __attribute__((ext_vector_type(2)));
typedef unsigned u32x4 __attribute__((ext_vector_type(4)));

constexpr int DM = 1024, NBATCH = 8, SEQL = 4096, CTXL = 256;
constexpr int ML = NBATCH * SEQL, MC = NBATCH * CTXL, MT = ML + MC;
constexpr int INW = 2560, DFF = 2816, UPW = 5632, MODW = 6144;
constexpr int QKW = 1280;
constexpr int UBCW = 768;
constexpr int VTR = 512;
constexpr float EPSN = 1e-6f;
constexpr int LDS_STAGE = 131072;
constexpr int LDS_TAB = LDS_STAGE + 16;
constexpr int LDS_BYTES = LDS_TAB + 91 * 80 * 4;

constexpr size_t SZ_WIN = (size_t)INW * DM * 2, SZ_WO = (size_t)DM * DM * 2, SZ_WUP = (size_t)UPW * DM * 2, SZ_WD = (size_t)DM * DFF * 2;
constexpr size_t WS_WIN = 0;
constexpr size_t WS_WO = WS_WIN + 2 * SZ_WIN;
constexpr size_t WS_WUP = WS_WO + 2 * SZ_WO;
constexpr size_t WS_WD = WS_WUP + 2 * SZ_WUP;
constexpr size_t WS_MOD = WS_WD + 2 * SZ_WD;
constexpr size_t WS_ROPE = WS_MOD + (size_t)2 * 9 * MODW * 4;
constexpr size_t WS_NG = WS_ROPE + 8192;
constexpr size_t WS_SM = WS_NG + 2048;
constexpr size_t WS_BAR = WS_SM + 256;
constexpr size_t WS_BAR_BYTES = 16384;
constexpr size_t WS_RB = WS_BAR + WS_BAR_BYTES;
constexpr size_t WS_X = WS_RB + (size_t)MT * DM * 2;
constexpr size_t WS_QK = WS_X;
constexpr size_t WS_UBC = WS_QK + (size_t)MT * QKW * 2;
constexpr size_t WS_VT = WS_UBC + (size_t)MT * UBCW * 2;
constexpr size_t WS_KB = WS_VT + (size_t)VTR * MT * 2;
constexpr size_t WS_Y = WS_KB + (size_t)8 * MT * 64 * 2;
constexpr size_t WS_ACT = WS_X;
constexpr size_t WS_UPB = WS_ACT + (size_t)MT * DFF * 2;
constexpr size_t WS_END_A = WS_Y + (size_t)MT * DM * 2, WS_END_B = WS_UPB + (size_t)(MT / 64) * 4 * UPW * 2;
constexpr size_t WS_PART = WS_END_A > WS_END_B ? WS_END_A : WS_END_B;
constexpr int PART_MAX = 11;
constexpr size_t WS_END = WS_PART + (size_t)PART_MAX * MC * DM * 4;

DI unsigned pk2(float lo, float hi) {
    typedef __bf16 bf2 __attribute__((ext_vector_type(2))); typedef float f2 __attribute__((ext_vector_type(2)));
    f2 v = {lo, hi}; bf2 r = __builtin_convertvector(v, bf2); return __builtin_bit_cast(unsigned, r);
}
DI float shx(float v, int o, int lane) { return __int_as_float(__builtin_amdgcn_ds_bpermute((lane ^ o) << 2, __float_as_int(v))); }
DI float bflo(unsigned u) { return __uint_as_float(u << 16); }
DI float bfhi(unsigned u) { return __uint_as_float(u & 0xffff0000u); }

namespace pg8 {
#define PG8_LAS __attribute__((address_space(3)))
typedef unsigned short bf16_t;
typedef short bf16x8 __attribute__((ext_vector_type(8)));
typedef float f32x4 __attribute__((ext_vector_type(4)));
typedef unsigned u32x4 __attribute__((ext_vector_type(4)));
constexpr int BM = 256, BK = 64, HALF = 128, HTB = HALF * BK * 2  , STAGE_BYTES = 8 * HTB, NXCD = 8, WGM = 8;

__host__ __device__ __forceinline__ int lds_byte(int r, int c) { const int st = (r >> 4) * 2 + (c >> 5), rr = r & 15, cc = c & 31, ob = rr * 64 + cc * 2; return st * 1024 + (ob ^ (((ob >> 9) & 1) << 5)); }
__host__ __device__ __forceinline__ void stage_rc(int b, int& R, int& C) { const int st = b / 1024, sb = b % 1024, swz = sb ^ (((sb >> 9) & 1) << 5); R = (st >> 1) * 16 + swz / 64; C = (st & 1) * 32 + (swz % 64) / 2; }
__host__ __device__ __forceinline__ int perm32(int rho) { const int n = rho >> 4, i = rho & 15; return 8 * (i >> 2) + 4 * n + (i & 3); }

struct Unit { int pm, pn, seg, kt0, nt; };
struct Gemm { const bf16_t* A; const bf16_t* Bt; int M, N, K, wv; };

struct StaticOrder {
    int nM, nN, nwg, G, c, ntk;
    __host__ __device__ void init(int M, int N, int G_, int c_) { nM = M / BM; nN = N / BM; nwg = nM * nN; G = G_; c = c_; ntk = 0; }
    __device__ __forceinline__ const char* a_ptr(const Gemm& g, const Unit& u) const { return (const char*)g.A + (size_t)u.pm * ((size_t)BM * g.K * 2); }
    __device__ __forceinline__ const char* b_ptr(const Gemm& g, const Unit& u) const { return (const char*)g.Bt + (size_t)u.pn * ((size_t)BM * g.K * 2); }
    __host__ __device__ bool next(int i, Unit& u) const {
        const long L = (long)i * G + c; if (L >= nwg) return false;
        int wgid = (int)L; { const int q = nwg / NXCD, r = nwg % NXCD, xcd = wgid % NXCD, off = wgid / NXCD; wgid = (xcd < r ? xcd * (q + 1) : r * (q + 1) + (xcd - r) * q) + off; }
        const int nig = WGM * nN, gid = wgid / nig, fm = gid * WGM, gsz = (nM - fm) < WGM ? (nM - fm) : WGM;
        u.pm = fm + ((wgid % nig) % gsz); u.pn = (wgid % nig) / gsz; u.seg = 0; u.kt0 = 0; u.nt = ntk; return true;
    }
    __device__ __forceinline__ void a_ready(const Unit&) const {}
    __device__ __forceinline__ void done(const Unit&) const {}
};

struct TwoSegOrder {
    StaticOrder s0; int n0, nM1, nN1, S, nt0, nt1, n1; const char* A1; const char* B1;
    __device__ void init(int M0, int N0, int K0tiles, const void* A1_, const void* B1_, int M1, int N1, int S_, int nt1_, int G_, int c_) {
        s0.init(M0, N0, G_, c_); s0.ntk = K0tiles; n0 = s0.nwg; nt0 = K0tiles; A1 = (const char*)A1_; B1 = (const char*)B1_; nM1 = M1 / BM; nN1 = N1 / BM; S = S_; nt1 = nt1_; n1 = nM1 * nN1 * S; }
    __device__ bool next(int i, Unit& u) const {
        const long L = (long)i * s0.G + s0.c;
        if (L < n0) return s0.next(i, u);
        const int w = (int)(L - n0); if (w >= n1) return false;
        const int tile = w / S, sp = w - tile * S; u.pm = tile / nN1; u.pn = tile - u.pm * nN1; u.seg = 1; u.kt0 = sp * nt1; u.nt = nt1; return true;
    }
    __device__ __forceinline__ const char* a_ptr(const Gemm& g, const Unit& u) const { return (u.seg ? A1 : (const char*)g.A) + (size_t)u.pm * ((size_t)BM * g.K * 2) + (size_t)u.kt0 * (BK * 2); }
    __device__ __forceinline__ const char* b_ptr(const Gemm& g, const Unit& u) const { return (u.seg ? B1 : (const char*)g.Bt) + (size_t)u.pn * ((size_t)BM * g.K * 2) + (size_t)u.kt0 * (BK * 2); }
    __device__ __forceinline__ void a_ready(const Unit&) const {}
    __device__ __forceinline__ void done(const Unit&) const {}
};
struct EpiBf16Plain {
    static constexpr bool PERM = true, AFTER_DRAIN = false, APERM = false;
    bf16_t* O; size_t ldc;
    __device__ __forceinline__ void operator()(const f32x4 (&acc)[2][2][4][2], const Unit& u, int wr, int wc, int fr, int fq) const {
        const int row0 = u.pm * BM + wr * 64 + fr, col0 = u.pn * BM + wc * 32 + 8 * fq;
#pragma unroll
        for (int ai = 0; ai < 2; ++ai)
#pragma unroll
            for (int m = 0; m < 4; ++m) { bf16_t* rowp = O + (size_t)(row0 + ai * HALF + m * 16) * ldc + col0;
#pragma unroll
                for (int bj = 0; bj < 2; ++bj) { const f32x4 v0 = acc[ai][bj][m][0], v1 = acc[ai][bj][m][1];
                    u32x4 o; o[0] = pk2(v0[0], v0[1]); o[1] = pk2(v0[2], v0[3]); o[2] = pk2(v1[0], v1[1]); o[3] = pk2(v1[2], v1[3]);
                    *(u32x4*)(rowp + bj * HALF) = o; } }
    }
};
struct EpiResid {
    static constexpr bool PERM = false, AFTER_DRAIN = false, APERM = false;
    const void* src; void* dst; int src_bf16, dst_bf16; bf16_t* PART; const float* gate;
    __device__ __forceinline__ void operator()(const f32x4 (&acc)[2][2][4][2], const Unit& u, int wr, int wc, int fr, int fq) const {
        const int rbase = u.pm * BM; const int b = u.seg ? 8 : (rbase >> 12);
        const int col0 = u.pn * BM + wc * 32 + 8 * fq;
        f32x4 gv[2][2];
#pragma unroll
        for (int bj = 0; bj < 2; ++bj)
#pragma unroll
            for (int n = 0; n < 2; ++n) gv[bj][n] = *(const f32x4*)(gate + (size_t)b * MODW + col0 + bj * HALF + n * 4);
        if (u.seg) {
            bf16_t* pp = PART + (size_t)(u.kt0 / u.nt) * ((size_t)MC * DM);
#pragma unroll
            for (int ai = 0; ai < 2; ++ai)
#pragma unroll
                for (int m = 0; m < 4; ++m) { bf16_t* dp = pp + (size_t)(rbase + wr * 64 + fr + ai * HALF + m * 16) * DM + col0;
#pragma unroll
                    for (int bj = 0; bj < 2; ++bj) { const f32x4 v0 = gv[bj][0] * acc[ai][bj][m][0], v1 = gv[bj][1] * acc[ai][bj][m][1]; u32x4 ob;
                        ob[0] = pk2(v0[0], v0[1]); ob[1] = pk2(v0[2], v0[3]); ob[2] = pk2(v1[0], v1[1]); ob[3] = pk2(v1[2], v1[3]); *(u32x4*)(dp + bj * HALF) = ob; } }
            return;
        }
        if (dst_bf16) body<1>(acc, gv, rbase, col0, wr, fr); else body<0>(acc, gv, rbase, col0, wr, fr);
    }
    template <int DB> __device__ __forceinline__ void body(const f32x4 (&acc)[2][2][4][2], const f32x4 (&gv)[2][2], int rbase, int col0, int wr, int fr) const {
        const bf16_t* sp = (const bf16_t*)src + (size_t)(rbase + wr * 64 + fr) * DM + col0;
#pragma unroll
        for (int ai = 0; ai < 2; ++ai)
#pragma unroll
            for (int m0 = 0; m0 < 4; m0 += 2) {
                u32x4 rb[2][2];
#pragma unroll
                for (int mm = 0; mm < 2; ++mm)
#pragma unroll
                    for (int bj = 0; bj < 2; ++bj) rb[mm][bj] = *(const u32x4*)(sp + (size_t)(ai * HALF + (m0 + mm) * 16) * DM + bj * HALF);
#pragma unroll
                for (int mm = 0; mm < 2; ++mm)
#pragma unroll
                    for (int bj = 0; bj < 2; ++bj) { const int m = m0 + mm; const size_t o = (size_t)(rbase + wr * 64 + fr + ai * HALF + m * 16) * DM + col0 + bj * HALF; const u32x4 q = rb[mm][bj]; f32x4 r0, r1;
                        r0[0] = bflo(q[0]); r0[1] = bfhi(q[0]); r0[2] = bflo(q[1]); r0[3] = bfhi(q[1]); r1[0] = bflo(q[2]); r1[1] = bfhi(q[2]); r1[2] = bflo(q[3]); r1[3] = bfhi(q[3]);
                        const f32x4 v0 = r0 + gv[bj][0] * acc[ai][bj][m][0], v1 = r1 + gv[bj][1] * acc[ai][bj][m][1];
                        if (DB) { u32x4 ob; ob[0] = pk2(v0[0], v0[1]); ob[1] = pk2(v0[2], v0[3]); ob[2] = pk2(v1[0], v1[1]); ob[3] = pk2(v1[2], v1[3]); *(u32x4*)((bf16_t*)dst + o) = ob; }
                        else { *(f32x4*)((float*)dst + o) = v0; *(f32x4*)((float*)dst + o + 4) = v1; } }
                __builtin_amdgcn_sched_barrier(0);
            }
    }
};
struct EpiInProj {
    static constexpr bool PERM = true, AFTER_DRAIN = false, APERM = false;
    bf16_t* QK; bf16_t* KB; bf16_t* UBC; bf16_t* VT; const float* ng; const PG8_LAS float* ropec; const PG8_LAS float* ropes;
    __device__ __forceinline__ void operator()(const f32x4 (&acc)[2][2][4][2], const Unit& u, int wr, int wc, int fr, int fq) const {
        if (u.seg) {
            const int r0v = u.pm * BM + wr * 64 + fr, c0v = u.pn * BM + wc * 32 + 8 * fq;
#pragma unroll
            for (int ai = 0; ai < 2; ++ai)
#pragma unroll
                for (int m = 0; m < 4; ++m) { const int r = r0v + ai * HALF + m * 16;
#pragma unroll
                    for (int bj = 0; bj < 2; ++bj) { const f32x4 v0 = acc[ai][bj][m][0], v1 = acc[ai][bj][m][1]; const int c = c0v + bj * HALF; u32x4 o;
                        o[0] = pk2(v0[0], v0[1]); o[1] = pk2(v0[2], v0[3]); o[2] = pk2(v1[0], v1[1]); o[3] = pk2(v1[2], v1[3]);
                        *(u32x4*)(VT + (((size_t)(r >> 6) * (MT / 8) + (c >> 3)) * 64 + (r & 63)) * 8) = o; } }
            return;
        }
        const int row0 = u.pm * BM + wr * 64 + fr;
        if (u.pn >= 5) {
            const int col0 = (u.pn - 5) * BM + wc * 32 + 8 * fq;
#pragma unroll
            for (int ai = 0; ai < 2; ++ai)
#pragma unroll
                for (int m = 0; m < 4; ++m) { bf16_t* rowp = UBC + (size_t)(row0 + ai * HALF + m * 16) * UBCW + col0;
#pragma unroll
                    for (int bj = 0; bj < 2; ++bj) { const f32x4 v0 = acc[ai][bj][m][0], v1 = acc[ai][bj][m][1]; u32x4 o;
                        o[0] = pk2(v0[0], v0[1]); o[1] = pk2(v0[2], v0[3]); o[2] = pk2(v1[0], v1[1]); o[3] = pk2(v1[2], v1[3]);
                        *(u32x4*)(rowp + bj * HALF) = o; } }
            return;
        }
        const int Hh = 4 * u.pn + wc;
        const float* g = ng + 64 * (Hh < 6 ? 0 : (Hh < 12 ? 1 : (Hh < 18 ? 2 : 3)));
        const float qs = (Hh < 6 || (Hh >= 12 && Hh < 18)) ? 0.125f * 1.4426950408889634f : 1.0f;
        const bool rope = Hh >= 12;
        f32x4 gv[2][2];
#pragma unroll
        for (int bj = 0; bj < 2; ++bj)
#pragma unroll
            for (int n = 0; n < 2; ++n) gv[bj][n] = *(const f32x4*)(g + bj * 32 + 8 * fq + 4 * n) * qs;
#pragma unroll
        for (int ai = 0; ai < 2; ++ai)
#pragma unroll
            for (int m = 0; m < 4; ++m) {
                const int row = row0 + ai * HALF + m * 16;
                float ss = 0.f;
#pragma unroll
                for (int bj = 0; bj < 2; ++bj)
#pragma unroll
                    for (int n = 0; n < 2; ++n) { const f32x4 v = acc[ai][bj][m][n]; ss += v[0] * v[0] + v[1] * v[1] + v[2] * v[2] + v[3] * v[3]; }
                ss += shx(ss, 16, fr + 16 * fq); ss += shx(ss, 32, fr + 16 * fq);
                const float rstd = rsqrtf(ss * (1.0f / 64.0f) + EPSN);
                f32x4 y[2][2];
#pragma unroll
                for (int bj = 0; bj < 2; ++bj)
#pragma unroll
                    for (int n = 0; n < 2; ++n) y[bj][n] = acc[ai][bj][m][n] * rstd * gv[bj][n];
                if (rope && row < ML) {
                    const int t = row & (SEQL - 1); const int pos = fq < 2 ? (t >> 6) : (t & 63);
#pragma unroll
                    for (int n = 0; n < 2; ++n) {
                        const f32x4 c4 = *(const PG8_LAS f32x4*)(ropec + pos * 16 + 8 * (fq & 1) + 4 * n), s4 = *(const PG8_LAS f32x4*)(ropes + pos * 16 + 8 * (fq & 1) + 4 * n);
                        const f32x4 x1 = y[0][n], x2 = y[1][n];
                        y[0][n] = x1 * c4 - x2 * s4; y[1][n] = x2 * c4 + x1 * s4; }
                }
                const bool isk = (Hh >= 6 && Hh < 12) || Hh >= 18;
                bf16_t* rowp = isk ? KB + (((size_t)(Hh < 12 ? Hh - 6 : Hh - 12) * (MT / 8) + (row >> 3)) * 8 + (fq >> 1) * 2 + (fq & 1)) * 64 + (row & 7) * 8
                                   : QK + ((size_t)row * 20 + Hh) * 64 + 8 * fq;
                const int sb = isk ? 256 : 32;
#pragma unroll
                for (int bj = 0; bj < 2; ++bj) { const f32x4 v0 = y[bj][0], v1 = y[bj][1]; u32x4 o;
                    o[0] = pk2(v0[0], v0[1]); o[1] = pk2(v0[2], v0[3]); o[2] = pk2(v1[0], v1[1]); o[3] = pk2(v1[2], v1[3]);
                    *(u32x4*)(rowp + bj * sb) = o; }
            }
    }
};
__device__ __forceinline__ float dpp_shr1(float v) { return __int_as_float(__builtin_amdgcn_update_dpp(0, __float_as_int(v), 0x111, 0xf, 0xf, true)); }
__device__ __forceinline__ float dpp_shl1(float v) { return __int_as_float(__builtin_amdgcn_update_dpp(0, __float_as_int(v), 0x101, 0xf, 0xf, true)); }
struct EpiUpConv {
    static constexpr bool PERM = false, AFTER_DRAIN = false, APERM = true;
    bf16_t* ACT; bf16_t* UPB; const float* cw;
    __device__ __forceinline__ void operator()(const f32x4 (&acc)[2][2][4][2], const Unit& u, int wr, int wc, int fr, int fq) const {
        const int ch0 = 128 * u.pn + 32 * wc + 8 * fq;
        f32x4 wa[2][3], wg[2][3];
#pragma unroll
        for (int n = 0; n < 2; ++n)
#pragma unroll
            for (int k = 0; k < 3; ++k) { wa[n][k] = *(const f32x4*)(cw + k * UPW + ch0 + 4 * n); wg[n][k] = *(const f32x4*)(cw + k * UPW + DFF + ch0 + 4 * n); }
#pragma unroll
        for (int ai = 0; ai < 2; ++ai) {
            const int rbase = u.pm * BM + ai * HALF + wr * 64;
            u32x4 o[4];
#pragma unroll
            for (int n = 0; n < 2; ++n) {
                f32x4 pa, pg, na, ng2;
#pragma unroll
                for (int e2 = 0; e2 < 4; ++e2) { pa[e2] = dpp_shr1(acc[ai][0][3][n][e2]); pg[e2] = dpp_shr1(acc[ai][1][3][n][e2]); na[e2] = dpp_shl1(acc[ai][0][0][n][e2]); ng2[e2] = dpp_shl1(acc[ai][1][0][n][e2]); }
#pragma unroll
                for (int m = 0; m < 4; ++m) {
                    const f32x4 xa = acc[ai][0][m][n], xg = acc[ai][1][m][n];
                    const f32x4 ya = m > 0 ? acc[ai][0][m > 0 ? m - 1 : 0][n] : pa, yg = m > 0 ? acc[ai][1][m > 0 ? m - 1 : 0][n] : pg;
                    const f32x4 za = m < 3 ? acc[ai][0][m < 3 ? m + 1 : 3][n] : na, zg = m < 3 ? acc[ai][1][m < 3 ? m + 1 : 3][n] : ng2;
                    const f32x4 a = wa[n][0] * ya + wa[n][1] * xa + wa[n][2] * za, g = wg[n][0] * yg + wg[n][1] * xg + wg[n][2] * zg;
                    float r[4];
#pragma unroll
                    for (int e2 = 0; e2 < 4; ++e2) r[e2] = a[e2] * __builtin_amdgcn_rcpf(1.0f + __expf(-a[e2])) * g[e2];
                    o[m][2 * n] = pk2(r[0], r[1]); o[m][2 * n + 1] = pk2(r[2], r[3]);
                }
            }
#pragma unroll
            for (int m = 0; m < 4; ++m) {
                const bool edge = (m == 0 && fr == 0) || (m == 3 && fr == 15);
                if (!edge) *(u32x4*)(ACT + (size_t)(rbase + 4 * fr + m) * DFF + ch0) = o[m];
            }
            if (fr == 0 || fr == 15) {
#pragma unroll
                for (int j = 0; j < 2; ++j) { const int m = fr == 0 ? j : 2 + j; bf16_t* up = UPB + ((size_t)(rbase >> 6) * 4 + (fr == 0 ? j : 2 + j)) * UPW + ch0;
#pragma unroll
                    for (int bj = 0; bj < 2; ++bj) { const f32x4 v0 = fr == 0 ? acc[ai][bj][j][0] : acc[ai][bj][2 + j][0], v1 = fr == 0 ? acc[ai][bj][j][1] : acc[ai][bj][2 + j][1]; u32x4 ro; (void)m;
                        ro[0] = pk2(v0[0], v0[1]); ro[1] = pk2(v0[2], v0[3]); ro[2] = pk2(v1[0], v1[1]); ro[3] = pk2(v1[2], v1[3]);
                        *(u32x4*)(up + bj * DFF) = ro; } }
            }
        }
    }
};
template <class Epi, class Sched, bool STAMP = false>
__device__ __forceinline__ void gemm_phase(PG8_LAS unsigned char* lds, const Gemm g, const Sched& S, const Epi& E, unsigned long long* stamps) {
    int lane_; asm volatile("v_mbcnt_lo_u32_b32 %0, -1, 0\n\tv_mbcnt_hi_u32_b32 %0, -1, %0" : "=v"(lane_)); const int tid = g.wv * 64 + lane_, wid = __builtin_amdgcn_readfirstlane(tid >> 6), lane = tid & 63, wr = wid >> 2, wc = wid & 3, fr = lane & 15, fq = lane >> 4;
    const int K = g.K;
    int ts_lo = 0, ts_hi = 0, nts = 0; const unsigned long long rt_entry = STAMP ? (unsigned long long)wall_clock64() : 0ull;
#define PG8_STAMP() do { if (STAMP && wid == 0 && nts < 64) { const unsigned long long _c = (unsigned long long)clock64(); \
        ts_lo = (lane == nts) ? (int)(unsigned)_c : ts_lo; ts_hi = (lane == nts) ? (int)(unsigned)(_c >> 32) : ts_hi; ++nts; } } while (0)
    PG8_STAMP();
    unsigned voffA[2], voffB[2];
#pragma unroll
    for (int i = 0; i < 2; ++i) { int R, C; stage_rc(tid * 16 + i * 8192, R, C); const int Rb = Epi::PERM ? ((R & ~31) + perm32(R & 31)) : R;
        const int Ra = Epi::APERM ? ((R & ~63) + 4 * (R & 15) + ((R >> 4) & 3)) : R;
        voffA[i] = (unsigned)(Ra * K + C) * 2u; voffB[i] = (unsigned)(Rb * K + C) * 2u; }
    const size_t kstep = (size_t)(BK * 2);
    const size_t hstep = (size_t)HALF * K * 2;
    const size_t tstep = 2 * hstep;
    const unsigned ldsw = (unsigned)wid * 1024u;
    const int aoff = lds_byte(wr * 64 + fr, fq * 8), boff = lds_byte(wc * 32 + fr, fq * 8);
#define PG8_SA(b, h) (((b) * 2 + (h)) * HTB)
#define PG8_SB(b, h) ((4 + (b) * 2 + (h)) * HTB)
#define PG8_STAGE(bufoff, gbase, voff) do { _Pragma("unroll") for (int _i = 0; _i < 2; ++_i) \
        __builtin_amdgcn_global_load_lds((const unsigned*)((const char*)(gbase) + (voff)[_i]), (PG8_LAS unsigned*)(lds + (bufoff) + ldsw + _i * 8192), 16, 0, 0); } while (0)
#define PG8_LDA(dst, b, h) do { _Pragma("unroll") for (int m = 0; m < 4; ++m) _Pragma("unroll") for (int k = 0; k < 2; ++k) dst[m][k] = *(const PG8_LAS bf16x8*)(lds + PG8_SA(b, h) + aoff + m * 2048 + k * 1024); } while (0)
#define PG8_LDB(dst, b, h) do { _Pragma("unroll") for (int n = 0; n < 2; ++n) _Pragma("unroll") for (int k = 0; k < 2; ++k) dst[n][k] = *(const PG8_LAS bf16x8*)(lds + PG8_SB(b, h) + boff + n * 2048 + k * 1024); } while (0)
#define PG8_MMA(ai, bj, At, Bt) do { __builtin_amdgcn_s_setprio(1); _Pragma("unroll") for (int m = 0; m < 4; ++m) _Pragma("unroll") for (int n = 0; n < 2; ++n) _Pragma("unroll") for (int k = 0; k < 2; ++k) \
        acc[ai][bj][m][n] = __builtin_amdgcn_mfma_f32_16x16x32_bf16(Bt[n][k], At[m][k], acc[ai][bj][m][n], 0, 0, 0); __builtin_amdgcn_s_setprio(0); } while (0)
#define PG8_WAIT_V(n) asm volatile("s_waitcnt vmcnt(" #n ")" ::: "memory")
#define PG8_WAIT_L(n) asm volatile("s_waitcnt lgkmcnt(" #n ")" ::: "memory")
#define PG8_BAR __builtin_amdgcn_s_barrier()
#define PG8_SCHED __builtin_amdgcn_sched_barrier(0)
    Unit cur, nxt; int ui = 0;
    if (!S.next(0, cur)) return;
    f32x4 acc[2][2][4][2];
#pragma unroll
    for (int a = 0; a < 2; ++a)
#pragma unroll
        for (int b = 0; b < 2; ++b)
#pragma unroll
            for (int m = 0; m < 4; ++m)
#pragma unroll
                for (int n = 0; n < 2; ++n) acc[a][b][m][n] = (f32x4){0.f, 0.f, 0.f, 0.f};
    bf16x8 At[4][2], B0[2][2], B1[2][2];
    const char* cA = S.a_ptr(g, cur); const char* cB = S.b_ptr(g, cur);
    S.a_ready(cur);
    PG8_STAGE(PG8_SB(0, 0), cB, voffB); PG8_STAGE(PG8_SA(0, 0), cA, voffA); PG8_STAGE(PG8_SB(0, 1), cB + hstep, voffB); PG8_STAGE(PG8_SA(0, 1), cA + hstep, voffA);
    if (wr == 1) PG8_BAR;
    PG8_WAIT_V(4); PG8_BAR;
    PG8_STAGE(PG8_SB(1, 0), cB + kstep, voffB); PG8_STAGE(PG8_SA(1, 0), cA + kstep, voffA); PG8_STAGE(PG8_SB(1, 1), cB + hstep + kstep, voffB);
    PG8_WAIT_V(6); PG8_BAR;
    PG8_STAMP();
    for (;;) {
        const bool has_next = S.next(ui + 1, nxt);
        const char* nA = has_next ? S.a_ptr(g, nxt) : cA; const char* nB = has_next ? S.b_ptr(g, nxt) : cB; const int nt = cur.nt;
        for (int t = 0; t < nt; t += 2) {
            const bool last = (t == nt - 2);
            const char* a1 = cA + (size_t)(t + 1) * kstep;
            const char* a2 = last ? nA : cA + (size_t)(t + 2) * kstep; const char* b2 = last ? nB : cB + (size_t)(t + 2) * kstep;
            const char* a3 = a2 + kstep; const char* b3 = b2 + kstep;
            if (last && has_next) S.a_ready(nxt);
            PG8_LDB(B0, 0, 0); PG8_SCHED; PG8_LDA(At, 0, 0); PG8_STAGE(PG8_SA(1, 1), a1 + hstep, voffA);
            PG8_WAIT_L(8); PG8_BAR; PG8_WAIT_L(0); PG8_MMA(0, 0, At, B0); PG8_BAR; PG8_SCHED;
            PG8_LDB(B1, 0, 1); PG8_STAGE(PG8_SB(0, 0), b2, voffB);
            PG8_BAR; PG8_WAIT_L(0); PG8_MMA(0, 1, At, B1); PG8_BAR;
            PG8_LDA(At, 0, 1); PG8_STAGE(PG8_SA(0, 0), a2, voffA);
            PG8_BAR; PG8_WAIT_L(0); PG8_MMA(1, 0, At, B0); PG8_BAR; PG8_SCHED;
            PG8_STAGE(PG8_SB(0, 1), b2 + hstep, voffB);
            PG8_WAIT_V(6); PG8_BAR; PG8_MMA(1, 1, At, B1); PG8_BAR;
            PG8_LDB(B0, 1, 0); PG8_SCHED; PG8_LDA(At, 1, 0); PG8_STAGE(PG8_SA(0, 1), a2 + hstep, voffA);
            PG8_WAIT_L(8); PG8_BAR; PG8_WAIT_L(0); PG8_MMA(0, 0, At, B0); PG8_BAR; PG8_SCHED;
            PG8_LDB(B1, 1, 1); PG8_STAGE(PG8_SB(1, 0), b3, voffB);
            PG8_BAR; PG8_WAIT_L(0); PG8_MMA(0, 1, At, B1); PG8_BAR;
            PG8_LDA(At, 1, 1); PG8_STAGE(PG8_SA(1, 0), a3, voffA);
            PG8_BAR; PG8_WAIT_L(0); PG8_MMA(1, 0, At, B0); PG8_BAR; PG8_SCHED;
            PG8_STAGE(PG8_SB(1, 1), b3 + hstep, voffB);
            PG8_WAIT_V(6); PG8_BAR; PG8_MMA(1, 1, At, B1); PG8_BAR;
        }
        PG8_STAMP();
        if constexpr (!Epi::AFTER_DRAIN) { E(acc, cur, wr, wc, fr, fq); S.done(cur); }
        PG8_STAMP();
        if (!has_next) break;
#pragma unroll
        for (int a = 0; a < 2; ++a)
#pragma unroll
            for (int b = 0; b < 2; ++b)
#pragma unroll
                for (int m = 0; m < 4; ++m)
#pragma unroll
                    for (int n = 0; n < 2; ++n) acc[a][b][m][n] = (f32x4){0.f, 0.f, 0.f, 0.f};
        cur = nxt; cA = nA; cB = nB; ++ui;
    }
    PG8_WAIT_V(0);
    if (wr == 0) PG8_BAR;
    PG8_BAR;
    if constexpr (Epi::AFTER_DRAIN) { E.fused(acc, cur, wr, wc, fr, fq, lds, wid, lane); S.done(cur); }
    PG8_STAMP();
    if (STAMP && wid == 0) { stamps[lane] = lane < nts ? (((unsigned long long)(unsigned)ts_hi << 32) | (unsigned)ts_lo) : 0ull;
        if (lane == 62) stamps[62] = rt_entry; if (lane == 63) stamps[63] = (unsigned long long)wall_clock64(); }
#undef PG8_STAMP
#undef PG8_SA
#undef PG8_SB
#undef PG8_STAGE
#undef PG8_LDA
#undef PG8_LDB
#undef PG8_MMA
#undef PG8_WAIT_V
#undef PG8_WAIT_L
#undef PG8_BAR
#undef PG8_SCHED
}
}
#define XB_TMO      128
#define XB_XCNT(j)  (256  + 64 * (j))
#define XB_XSUB(j)  (1280 + 64 * (j))
#define XB_XGEN(j)  (2304 + 64 * (j))
#define XB_TOP      3328
#define XB_TOPGEN   3392
#define XCD_BAR_WORDS 3456
#define XB_SPIN_CAP (1u << 18)
#define LAS __attribute__((address_space(3)))

__device__ __forceinline__ unsigned xb_ld(unsigned* p)              { return __hip_atomic_load(p, __ATOMIC_RELAXED, __HIP_MEMORY_SCOPE_AGENT); }
__device__ __forceinline__ unsigned xb_add(unsigned* p, unsigned v) { return __hip_atomic_fetch_add(p, v, __ATOMIC_RELAXED, __HIP_MEMORY_SCOPE_AGENT); }
__device__ __forceinline__ unsigned xb_xcc_id() { return (unsigned)__builtin_amdgcn_s_getreg((3 << 11) | 20) & 0xFu; }
#define XB_SPIN(cond, bar) do { unsigned _sp = 0; while (cond) { __builtin_amdgcn_s_sleep(1); \
    if ((++_sp & 255u) == 0u) { if (xb_ld(&(bar)[XB_TMO])) break; if (_sp > XB_SPIN_CAP) { atomicAdd(&(bar)[XB_TMO], 1u); break; } } } } while (0)

struct XcdBarrier {
    unsigned* bar; unsigned x;
    volatile LAS unsigned* st;
};

__device__ __forceinline__ XcdBarrier xcd_barrier_post(unsigned* bar, volatile LAS unsigned* st) {
    XcdBarrier b; b.bar = bar; b.x = xb_xcc_id(); b.st = st;
    if (threadIdx.x == 0) (void)xb_add(&bar[XB_XCNT(b.x)], 1u);
    return b;
}
__device__ __forceinline__ void xcd_barrier_complete(unsigned* bar, unsigned x, unsigned& nloc, unsigned& nx) {
    const unsigned G = gridDim.x * gridDim.y * gridDim.z;
    unsigned sum, cnt, mine, sp = 0u;
    for (;;) {
        sum = 0u; cnt = 0u; mine = 0u;
#pragma unroll
        for (unsigned j = 0; j < 16; ++j) { const unsigned c = xb_ld(&bar[XB_XCNT(j)]); sum += c; cnt += (c > 0u) ? 1u : 0u; mine = (j == x) ? c : mine; }
        if (sum == G) break;
        __builtin_amdgcn_s_sleep(1);
        if ((++sp & 255u) == 0u) { if (xb_ld(&bar[XB_TMO])) break; if (sp > XB_SPIN_CAP) { atomicAdd(&bar[XB_TMO], 1u); break; } }
    }
    nloc = mine > 0u ? mine : 1u; nx = cnt > 0u ? cnt : 1u;
}

__device__ __forceinline__ void xcd_barrier(const XcdBarrier& b, bool is_t0) {
    asm volatile("s_waitcnt vmcnt(0)" ::: "memory");
    __syncthreads();
    if (is_t0) {
        unsigned* bar = b.bar;
        __builtin_amdgcn_s_waitcnt(0);
        unsigned nloc = b.st[0], nx = b.st[1];
        if (nloc == 0u) { xcd_barrier_complete(bar, b.x, nloc, nx); b.st[0] = nloc; b.st[1] = nx; }
        const unsigned old = xb_add(&bar[XB_XSUB(b.x)], 1u);
        const unsigned gen = old / nloc;
        if (old + 1u == (gen + 1u) * nloc) {
            __builtin_amdgcn_fence(__ATOMIC_RELEASE, "agent");
            asm volatile("s_waitcnt vmcnt(0)" ::: "memory");
            const unsigned og = xb_add(&bar[XB_TOP], 1u);
            const unsigned tg = og / nx;
            if (og + 1u == (tg + 1u) * nx) xb_add(&bar[XB_TOPGEN], 1u);
            else XB_SPIN(xb_ld(&bar[XB_TOPGEN]) == tg, bar);
            __builtin_amdgcn_fence(__ATOMIC_ACQUIRE, "agent");
            xb_add(&bar[XB_XGEN(b.x)], 1u);
            asm volatile("s_waitcnt vmcnt(0)" ::: "memory");
        } else {
            XB_SPIN(xb_ld(&bar[XB_XGEN(b.x)]) == gen, bar);
            __builtin_amdgcn_fence(__ATOMIC_ACQUIRE, "agent");
            asm volatile("s_waitcnt vmcnt(0)" ::: "memory");
        }
    }
    __syncthreads();
}

static_assert(XCD_BAR_WORDS * 4 <= 16384, "barrier words");
using pg8::f32x4; using pg8::bf16_t; using pg8::bf16x8;

struct Params { const float* in[20]; float* out; unsigned char* ws; int ph_lo, ph_hi; };
enum { I_X = 0, I_C, I_CTX, I_CCTX, I_WADA, I_BADA, I_GATTN, I_WIN, I_QNA, I_KNA, I_QNB, I_KNB, I_RPB, I_SINK, I_CONVC, I_WO, I_GFFN, I_WUP, I_CONVF, I_WDOWN };

DI int ltid(int wv) { int lane; asm volatile("v_mbcnt_lo_u32_b32 %0, -1, 0\n\tv_mbcnt_hi_u32_b32 %0, -1, %0" : "=v"(lane)); return wv * 64 + lane; }
DI float wave_sum(float v, int lane) {
#pragma unroll
    for (int o = 32; o >= 1; o >>= 1) v += shx(v, o, lane);
    return v;
}

DI int win_src_col(int n) {
    if (n < 1280) { const int pn = n >> 8, cs = n & 255, bj = cs >> 7, wc = (cs & 127) >> 5, w = cs & 31, Hh = 4 * pn + wc;
        const int hc = Hh < 6 ? 64 * Hh : (Hh < 12 ? 384 + 64 * (Hh - 6) : (Hh < 18 ? 1152 + 64 * (Hh - 12) : 1536 + 64 * (Hh - 18)));
        return hc + 32 * bj + w; }
    if (n < 2048) return 1792 + (n - 1280);
    const int v = n - 2048; return v < 384 ? 768 + v : 1664 + (v - 384);
}
constexpr float LOG2E_ = 1.4426950408889634f;
DI int perm8_col(int n) { const int w = n & 31; return (n & ~31) + 8 * ((w >> 2) & 3) + 4 * (w >> 4) + (w & 3); }
DI int wup_src_col(int n) {
    const int pn = n >> 8, cs = n & 255, bj = cs >> 7, j = cs & 127, wc = j >> 5, n_ = (j >> 4) & 1, fq = (j >> 2) & 3, e = j & 3;
    return bj * DFF + 128 * pn + 32 * wc + 8 * fq + 4 * n_ + e;
}
struct TtTile { const float* src; bf16_t* dst; int which, K, srcN, n0, k0; };
DI TtTile tt_decode(const Params& p, unsigned char* ws, int t) {
    TtTile d; const int l = t / 3008; int r = t % 3008; int tn, tk;
    if (r < 640) { d.which = 0; tn = r >> 4; tk = r & 15; d.K = 1024; d.srcN = INW; }
    else if (r < 896) { r -= 640; d.which = 1; tn = r >> 4; tk = r & 15; d.K = 1024; d.srcN = DM; }
    else if (r < 2304) { r -= 896; d.which = 2; tn = r >> 4; tk = r & 15; d.K = 1024; d.srcN = UPW; }
    else { r -= 2304; d.which = 3; tn = r / 44; tk = r % 44; d.K = DFF; d.srcN = DM; }
    d.src = d.which == 0 ? p.in[I_WIN] + (size_t)l * DM * INW : (d.which == 1 ? p.in[I_WO] + (size_t)l * DM * DM : (d.which == 2 ? p.in[I_WUP] + (size_t)l * DM * UPW : p.in[I_WDOWN] + (size_t)l * DFF * DM));
    d.dst = (bf16_t*)(ws + (d.which == 0 ? WS_WIN + l * SZ_WIN : (d.which == 1 ? WS_WO + l * SZ_WO : (d.which == 2 ? WS_WUP + l * SZ_WUP : WS_WD + l * SZ_WD))));
    d.n0 = tn * 64; d.k0 = tk * 64; return d;
}
DI void tt_load(float (&v)[8], const TtTile& d, int tid) {
    const int n4 = tid & 15, kb = tid >> 4; const int nd = d.n0 + 4 * n4; const int sc = d.which == 0 ? win_src_col(nd) : (d.which == 2 ? wup_src_col(nd) : perm8_col(nd));
#pragma unroll
    for (int i = 0; i < 2; ++i) { const f32x4 x = *(const f32x4*)(d.src + (size_t)(d.k0 + kb + 32 * i) * d.srcN + sc); v[4 * i] = x[0]; v[4 * i + 1] = x[1]; v[4 * i + 2] = x[2]; v[4 * i + 3] = x[3]; }
}
DI void transpose_tiles(const Params& p, int wvs, float* sm, int t_begin, int t_end, int rank, int nranks) {
    const int tid = ltid(wvs); unsigned char* ws = p.ws;
    int t = t_begin + rank; if (t >= t_end) return;
    TtTile d = tt_decode(p, ws, t); float cur[8]; tt_load(cur, d, tid);
#pragma unroll 1
    for (;;) {
        const int t2 = t + nranks; const bool has = t2 < t_end;
        const TtTile d2 = tt_decode(p, ws, has ? t2 : t); float nxt[8];
        if (has) tt_load(nxt, d2, tid);
        { const int n4 = tid & 15, kb = tid >> 4;
#pragma unroll
          for (int i = 0; i < 2; ++i)
#pragma unroll
              for (int e = 0; e < 4; ++e) sm[(kb + 32 * i) * 65 + 4 * n4 + e] = cur[4 * i + e]; }
        __syncthreads();
        { const int n = tid >> 3, kg = tid & 7; float v[8];
#pragma unroll
          for (int j = 0; j < 8; ++j) v[j] = sm[(8 * kg + j) * 65 + n];
          u32x4 o; o[0] = pk2(v[0], v[1]); o[1] = pk2(v[2], v[3]); o[2] = pk2(v[4], v[5]); o[3] = pk2(v[6], v[7]);
          *(u32x4*)(d.dst + (size_t)(d.n0 + n) * d.K + d.k0 + 8 * kg) = o; }
        __syncthreads();
        if (!has) break;
        t = t2; d = d2;
#pragma unroll
        for (int i = 0; i < 8; ++i) cur[i] = nxt[i];
    }
}
DI void phase_prep(const Params& p, int wvs, float* sm) {
    const int tid = ltid(wvs); unsigned char* ws = p.ws;
    if (blockIdx.x == gridDim.x - 1) {
        float* rc = (float*)(ws + WS_ROPE); float* rs = rc + 1024;
        for (int e = tid; e < 1024; e += 512) { const int pos = e >> 4, f = e & 15;
            float invf = 1.0f;
#define IV(i, v) invf = (f == (i)) ? (v) : invf
            IV(1, 0.5623413324356079f); IV(2, 0.3162277638912201f); IV(3, 0.17782793939113617f); IV(4, 0.10000000149011612f); IV(5, 0.05623413249850273f); IV(6, 0.03162277489900589f); IV(7, 0.017782794311642647f);
            IV(8, 0.009999999776482582f); IV(9, 0.005623413249850273f); IV(10, 0.003162277629598975f); IV(11, 0.0017782794311642647f); IV(12, 0.0010000000474974513f); IV(13, 0.000562341301701963f); IV(14, 0.0003162277571391314f); IV(15, 0.00017782794020604342f);
#undef IV
            const float ang = (float)pos * invf; const double x = (double)ang;
            const double n = rint(x * 0.15915494309189535); const double r = x - n * 6.283185307179586476925; const double r2 = r * r;
            double c = 1.0, s = r, tc = 1.0, tsn = r;
#pragma unroll 1
            for (int i = 1; i <= 15; ++i) { tc *= -r2 / (double)((2 * i - 1) * (2 * i)); c += tc; tsn *= -r2 / (double)((2 * i) * (2 * i + 1)); s += tsn; }
            rc[e] = (float)c; rs[e] = (float)s; }
        { float* ng = (float*)(ws + WS_NG); const int l = tid >> 8, w = (tid >> 6) & 3, d = tid & 63;
          const float* s0 = w == 0 ? p.in[I_QNA] : (w == 1 ? p.in[I_KNA] : (w == 2 ? p.in[I_QNB] : p.in[I_KNB])); ng[tid] = s0[l * 64 + d]; }
        for (int l = 0; l < 2; ++l) {
            if (tid < 64) { sm[tid * 8 + 0] = fabsf(p.in[I_QNA][l * 64 + tid]); sm[tid * 8 + 1] = fabsf(p.in[I_KNA][l * 64 + tid]); sm[tid * 8 + 2] = fabsf(p.in[I_QNB][l * 64 + tid]); sm[tid * 8 + 3] = fabsf(p.in[I_KNB][l * 64 + tid]);
                sm[tid * 8 + 5] = tid < 6 ? p.in[I_SINK][l * 6 + tid] : -1e30f; }
            { float bm = 0.f;
#pragma unroll
              for (int k = 0; k < 6; ++k) { const int i = tid + 512 * k; bm = fmaxf(bm, i < 6 * 15 * 31 ? p.in[I_RPB][l * 2790 + i] : 0.f); }
              sm[512 + tid] = bm; }
            __syncthreads();
            if (tid < 64) { float bm = 0.f;
#pragma unroll
              for (int k = 0; k < 8; ++k) bm = fmaxf(bm, sm[512 + tid + 64 * k]);
              sm[tid * 8 + 4] = bm; }
            __syncthreads();
            if (tid == 0) { float g0 = 0.f, g1 = 0.f, g2 = 0.f, g3 = 0.f, bm = 0.f, sk = -1e30f;
                for (int i = 0; i < 64; ++i) { g0 = fmaxf(g0, sm[i * 8]); g1 = fmaxf(g1, sm[i * 8 + 1]); g2 = fmaxf(g2, sm[i * 8 + 2]); g3 = fmaxf(g3, sm[i * 8 + 3]); bm = fmaxf(bm, sm[i * 8 + 4]); sk = fmaxf(sk, sm[i * 8 + 5]); }
                const float qk = 0.125f * 64.0f * LOG2E_ * 1.01f; float* sm2 = (float*)(ws + WS_SM);
                sm2[l * 2 + 0] = qk * g0 * g1 + LOG2E_ * bm; sm2[l * 2 + 1] = fmaxf(qk * g2 * g3, LOG2E_ * sk); }
            __syncthreads();
        }
    }
    {
        float* scv = sm; float* red = sm + 9 * 1024;
        bool loaded = false;
        for (int it = blockIdx.x; it < 192; it += gridDim.x) {
            if (!loaded) { float cv[18];
#pragma unroll
                for (int k = 0; k < 18; ++k) { const int i = tid + 512 * k; cv[k] = i < 8192 ? p.in[I_C][i] : p.in[I_CCTX][i - 8192]; }
#pragma unroll
                for (int k = 0; k < 18; ++k) scv[tid + 512 * k] = cv[k] / (1.0f + __expf(-cv[k]));
                loaded = true; __syncthreads(); }
            const int l = it / 96, j0 = (it % 96) * 64, tx = tid & 15, ty = tid >> 4;
            f32x4 a[9];
#pragma unroll
            for (int b = 0; b < 9; ++b) a[b] = (f32x4){0.f, 0.f, 0.f, 0.f};
            const float* wp = p.in[I_WADA] + (size_t)l * DM * MODW + j0 + 4 * tx;
#pragma unroll 16
            for (int i = 0; i < 32; ++i) { const int k = ty + 32 * i; const f32x4 w4 = *(const f32x4*)(wp + (size_t)k * MODW);
#pragma unroll
                for (int b = 0; b < 9; ++b) a[b] += w4 * scv[b * 1024 + k]; }
#pragma unroll
            for (int b = 0; b < 9; ++b) *(f32x4*)(red + (ty * 9 + b) * 64 + 4 * tx) = a[b];
            __syncthreads();
            for (int o = tid; o < 576; o += 512) { const int b = o >> 6, ci = o & 63; float s = 0.f;
                for (int y = 0; y < 32; ++y) s += red[(y * 9 + b) * 64 + ci];
                ((float*)(ws + WS_MOD))[(size_t)(l * 9 + b) * MODW + j0 + ci] = s + p.in[I_BADA][l * MODW + j0 + ci]; }
            __syncthreads();
        }
        __syncthreads();
    }
}

struct PnSrc { const float* latf; const bf16_t* latb; const float* ctxf; const bf16_t* ctxb; const bf16_t* parts; int nparts; bf16_t* rc_out; bf16_t* lat_out; };
DI void pn_load(f32x4 (&v)[4], const PnSrc& S, int row, int lane) {
    const bool isl = row < ML; const size_t ro = (size_t)(isl ? row : row - ML) * DM + 8 * lane;
    const float* sf = isl ? S.latf : S.ctxf; const bf16_t* sb = isl ? S.latb : S.ctxb;
    if (sb) {
#pragma unroll
        for (int c = 0; c < 2; ++c) { const u32x4 rb = *(const u32x4*)(sb + ro + 512 * c);
            v[2 * c][0] = bflo(rb[0]); v[2 * c][1] = bfhi(rb[0]); v[2 * c][2] = bflo(rb[1]); v[2 * c][3] = bfhi(rb[1]); v[2 * c + 1][0] = bflo(rb[2]); v[2 * c + 1][1] = bfhi(rb[2]); v[2 * c + 1][2] = bflo(rb[3]); v[2 * c + 1][3] = bfhi(rb[3]); }
    } else {
#pragma unroll
        for (int i = 0; i < 4; ++i) v[i] = *(const f32x4*)(sf + ro + (i >> 1) * 512 + 4 * (i & 1));
    }
}
DI void pn_finish(f32x4 (&v)[4], const PnSrc& S, int row, int lane, const f32x4 (&g4)[4], const float* modl, int shoff, int scoff, bf16_t* H) {
    const bool isl = row < ML; const size_t ro = (size_t)(isl ? row : row - ML) * DM + 8 * lane; const int b = isl ? (row >> 12) : 8;
    if (!isl && S.nparts > 0) {
        const bf16_t* pr = S.parts + ro;
#pragma unroll 1
        for (int s = 0; s < S.nparts; ++s) {
#pragma unroll
            for (int c = 0; c < 2; ++c) { const u32x4 rb = *(const u32x4*)(pr + (size_t)s * MC * DM + 512 * c);
                v[2 * c][0] += bflo(rb[0]); v[2 * c][1] += bfhi(rb[0]); v[2 * c][2] += bflo(rb[1]); v[2 * c][3] += bfhi(rb[1]); v[2 * c + 1][0] += bflo(rb[2]); v[2 * c + 1][1] += bfhi(rb[2]); v[2 * c + 1][2] += bflo(rb[3]); v[2 * c + 1][3] += bfhi(rb[3]); } }
        if (S.rc_out) {
#pragma unroll
            for (int c = 0; c < 2; ++c) { u32x4 ob; ob[0] = pk2(v[2 * c][0], v[2 * c][1]); ob[1] = pk2(v[2 * c][2], v[2 * c][3]); ob[2] = pk2(v[2 * c + 1][0], v[2 * c + 1][1]); ob[3] = pk2(v[2 * c + 1][2], v[2 * c + 1][3]);
                *(u32x4*)(S.rc_out + ro + 512 * c) = ob; } }
    }
    if (isl && S.lat_out) {
#pragma unroll
        for (int c = 0; c < 2; ++c) { u32x4 ob; ob[0] = pk2(v[2 * c][0], v[2 * c][1]); ob[1] = pk2(v[2 * c][2], v[2 * c][3]); ob[2] = pk2(v[2 * c + 1][0], v[2 * c + 1][1]); ob[3] = pk2(v[2 * c + 1][2], v[2 * c + 1][3]);
            *(u32x4*)(S.lat_out + ro + 512 * c) = ob; } }
    float ss = 0.f;
#pragma unroll
    for (int i = 0; i < 4; ++i) ss += v[i][0] * v[i][0] + v[i][1] * v[i][1] + v[i][2] * v[i][2] + v[i][3] * v[i][3];
    ss = wave_sum(ss, lane); const float rstd = rsqrtf(ss * (1.0f / 1024.0f) + EPSN);
    const float* mb = modl + (size_t)b * MODW;
    f32x4 y[4];
#pragma unroll
    for (int i = 0; i < 4; ++i) { const int col = (i >> 1) * 512 + 8 * lane + 4 * (i & 1); const f32x4 sc4 = *(const f32x4*)(mb + scoff + col), sh4 = *(const f32x4*)(mb + shoff + col);
        y[i] = v[i] * rstd * g4[i] * (sc4 + 1.0f) + sh4; }
#pragma unroll
    for (int c = 0; c < 2; ++c) { u32x4 o; o[0] = pk2(y[2 * c][0], y[2 * c][1]); o[1] = pk2(y[2 * c][2], y[2 * c][3]); o[2] = pk2(y[2 * c + 1][0], y[2 * c + 1][1]); o[3] = pk2(y[2 * c + 1][2], y[2 * c + 1][3]);
        *(u32x4*)(H + (size_t)row * DM + 512 * c + 8 * lane) = o; }
}
DI void phase_prenorm(int wvs, const float* latf, const bf16_t* latb, const float* ctxf, const bf16_t* ctxb, const float* g, const float* modl, int shoff, int scoff, bf16_t* H, int nrows, const bf16_t* parts, int nparts, bf16_t* rc_out, bf16_t* lat_out) {
    const int tid = ltid(wvs); const int lane = tid & 63, gw = blockIdx.x * 8 + __builtin_amdgcn_readfirstlane(tid >> 6), nw = gridDim.x * 8;
    const PnSrc S{latf, latb, ctxf, ctxb, parts, nparts, rc_out, lat_out};
    f32x4 g4[4];
#pragma unroll
    for (int i = 0; i < 4; ++i) g4[i] = *(const f32x4*)(g + (i >> 1) * 512 + 8 * lane + 4 * (i & 1));
    for (int row = gw; row < nrows; row += 2 * nw) {
        const int row2 = row + nw; const bool has2 = row2 < nrows;
        f32x4 va[4], vb[4];
        pn_load(va, S, row, lane);
        if (has2) pn_load(vb, S, row2, lane);
        pn_finish(va, S, row, lane, g4, modl, shoff, scoff, H);
        if (has2) pn_finish(vb, S, row2, lane, g4, modl, shoff, scoff, H);
    }
}

DI void unpack8(const u32x4 u, float (&f)[8]) {
#pragma unroll
    for (int i = 0; i < 4; ++i) { f[2 * i] = bflo(u[i]); f[2 * i + 1] = bfhi(u[i]); }
}
DI void phase_fixup(int wvs, const bf16_t* UPB, bf16_t* ACT, const float* cw  , int nrows) {
    const int tid = ltid(wvs);
    const int total = (nrows >> 6) * 2 * 352; const int stride = gridDim.x * 512;
    for (int i = blockIdx.x * 512 + tid; i < total; i += stride) {
        const int cg8 = i % 352, j = i / 352, side = j & 1, blk = j >> 1, c = cg8 * 8; const int row = blk * 64 + (side ? 63 : 0);
        int t, L; if (row < ML) { t = row & (SEQL - 1); L = SEQL; } else { t = (row - ML) & (CTXL - 1); L = CTXL; }
        const bf16_t* rp[3];
        rp[1] = UPB + ((size_t)blk * 4 + (side ? 3 : 0)) * UPW + c;
        rp[0] = side ? UPB + ((size_t)blk * 4 + 2) * UPW + c : UPB + ((size_t)(blk - 1) * 4 + 3) * UPW + c;
        rp[2] = side ? UPB + ((size_t)(blk + 1) * 4 + 0) * UPW + c : UPB + ((size_t)blk * 4 + 1) * UPW + c;
        float a[8], g[8];
#pragma unroll
        for (int q = 0; q < 8; ++q) { a[q] = 0.f; g[q] = 0.f; }
#pragma unroll
        for (int k = 0; k < 3; ++k) {
            if ((k == 0 && t == 0) || (k == 2 && t == L - 1)) continue;
            float ua[8], ug[8]; unpack8(*(const u32x4*)rp[k], ua); unpack8(*(const u32x4*)(rp[k] + DFF), ug);
            const f32x4 wa0 = *(const f32x4*)(cw + k * UPW + c), wa1 = *(const f32x4*)(cw + k * UPW + c + 4), wg0 = *(const f32x4*)(cw + k * UPW + DFF + c), wg1 = *(const f32x4*)(cw + k * UPW + DFF + c + 4);
#pragma unroll
            for (int q = 0; q < 4; ++q) { a[q] += ua[q] * wa0[q]; a[4 + q] += ua[4 + q] * wa1[q]; g[q] += ug[q] * wg0[q]; g[4 + q] += ug[4 + q] * wg1[q]; }
        }
        float o[8];
#pragma unroll
        for (int q = 0; q < 8; ++q) o[q] = a[q] / (1.0f + __expf(-a[q])) * g[q];
        u32x4 ov; ov[0] = pk2(o[0], o[1]); ov[1] = pk2(o[2], o[3]); ov[2] = pk2(o[4], o[5]); ov[3] = pk2(o[6], o[7]);
        *(u32x4*)(ACT + (size_t)row * DFF + c) = ov;
    }
}

#define MFMA32(a, b, c) __builtin_amdgcn_mfma_f32_32x32x16_bf16((a), (b), (c), 0, 0, 0)
constexpr int RPB_PITCH = 80, RPB_SHIFT = 24;
constexpr float LOG2E = 1.4426950408889634f;
struct AttnAcc { f32x16 o0, o1; float l; };
struct TileLd { bf16x8 k[4]; bf16x8 v[4]; };
struct MBNone { float negM; DI float operator()(int, float s) const { return s + negM; } };
template <int REM> struct MBGen {
    const float* bl; int v0; unsigned width;
    DI float operator()(int r, float s) const {
        const int off = REM ? (r & 7) : 16 * (r >> 3) + (r & 7);
        const float bias = bl[REM ? (2 * (r >> 3)) * RPB_PITCH + (r & 7) : off];
        return ((unsigned)(off - v0) < width) ? s + bias : -1e30f;
    }
};
DI void tile_load(TileLd& L, const bf16_t* kp, const bf16_t* vA, const bf16_t* vB) {
#pragma unroll
    for (int kk = 0; kk < 4; ++kk) L.k[kk] = *(const bf16x8*)(kp + 128 * kk);
    L.v[0] = *(const bf16x8*)vA; L.v[1] = *(const bf16x8*)vB; L.v[2] = *(const bf16x8*)(vA + 256); L.v[3] = *(const bf16x8*)(vB + 256);
}
DI f32x16 tile_qk(const bf16x8 (&qf)[4], const TileLd& L) {
    f32x16 s;
#pragma unroll
    for (int r = 0; r < 16; ++r) s[r] = 0.f;
#pragma unroll
    for (int kk = 0; kk < 4; ++kk) s = MFMA32(L.k[kk], qf[kk], s);
    return s;
}
typedef __attribute__((address_space(3))) unsigned char lds_u8;
DI void tile_load_lds(TileLd& L, const lds_u8* kp, const lds_u8* vA) {
#pragma unroll
    for (int kk = 0; kk < 4; ++kk) L.k[kk] = *(const __attribute__((address_space(3))) bf16x8*)(kp + 256 * kk);
    L.v[0] = *(const __attribute__((address_space(3))) bf16x8*)vA; L.v[1] = *(const __attribute__((address_space(3))) bf16x8*)(vA + 2048);
    L.v[2] = *(const __attribute__((address_space(3))) bf16x8*)(vA + 512); L.v[3] = *(const __attribute__((address_space(3))) bf16x8*)(vA + 2048 + 512);
}
template <class MB> DI void tile_rest(AttnAcc& a, f32x16 s, const TileLd& L, const MB& mb) {
    float ls = 0.f;
#pragma unroll
    for (int r = 0; r < 16; ++r) { const float pv = __builtin_amdgcn_exp2f(mb(r, s[r])); ls += pv; s[r] = pv; }
    a.l += ls;
    u32x4 p0, p1;
#pragma unroll
    for (int j = 0; j < 4; ++j) { p0[j] = pk2(s[2 * j], s[2 * j + 1]); p1[j] = pk2(s[8 + 2 * j], s[8 + 2 * j + 1]); }
    const bf16x8 pb0 = __builtin_bit_cast(bf16x8, p0), pb1 = __builtin_bit_cast(bf16x8, p1);
    a.o0 = MFMA32(L.v[0], pb0, a.o0); a.o0 = MFMA32(L.v[1], pb1, a.o0);
    a.o1 = MFMA32(L.v[2], pb0, a.o1); a.o1 = MFMA32(L.v[3], pb1, a.o1);
}

template <int probe> DI void attn_item(int lane, int type, int idx, const bf16_t* QK, const bf16_t* KB, const bf16_t* VT, bf16_t* Y, const float* tab, const float* sink, const float* shifts, const lds_u8* limg) {
    const int q = lane & 31, h = lane >> 5;
    const int pi = 16 * (q >> 4) + 8 * ((q >> 2) & 1) + 4 * ((q >> 3) & 1) + (q & 3);
    int head, b, qrow, Hq, Hk, vrow0, ocol; bool has_sink;
    int jj = 0, rq = 0, t0 = 0, nt = 8, m_lo = 0;
    if (type == 0) { head = idx % 6; int t = idx / 6; jj = t & 1; t >>= 1; rq = t & 63; b = t >> 6; qrow = b * SEQL + rq * 64 + 32 * jj + q; Hq = head; Hk = 6 + head; vrow0 = 64 * head; ocol = 64 * head; has_sink = false; nt = 18; }
    else if (type == 1) { head = idx % 6; int t = idx / 6; const int qb = t & 127; b = t >> 7; t0 = qb * 32; qrow = b * SEQL + t0 + q; Hq = 12 + head; Hk = 18 + head / 3; vrow0 = 384 + 64 * (head / 3); ocol = 384 + 64 * head; has_sink = true;
        m_lo = t0 < 128 ? (128 - t0) >> 5 : 0; const int m_hi = min(8, (4192 - t0) >> 5); nt = 8 + m_hi - m_lo + 1; }
    else { head = idx % 6; int t = idx / 6; const int qb = t & 7; b = t >> 3; qrow = ML + b * CTXL + qb * 32 + q;
        if (type == 2) { Hq = head; Hk = 6 + head; vrow0 = 64 * head; ocol = 64 * head; has_sink = false; }
        else { Hq = 12 + head; Hk = 18 + head / 3; vrow0 = 384 + 64 * (head / 3); ocol = 384 + 64 * head; has_sink = true; } }
    if (probe & 2) nt = 2;
    bf16x8 qf[4];
    { const bf16_t* qp = QK + ((size_t)qrow * 20 + Hq) * 64 + 8 * h;
#pragma unroll
      for (int kk = 0; kk < 4; ++kk) qf[kk] = *(const bf16x8*)(qp + 16 * kk); }
    AttnAcc a;
#pragma unroll
    for (int r = 0; r < 16; ++r) { a.o0[r] = 0.f; a.o1[r] = 0.f; }
    const float negM = -shifts[(type & 1)];
    a.l = (has_sink && h == 0) ? __builtin_amdgcn_exp2f(sink[head] * LOG2E + negM) : 0.f;
    const int kvhead = Hk < 12 ? Hk - 6 : Hk - 12;
    const bf16_t* Kh = KB + (size_t)kvhead * (MT / 8) * 512 + 64 * h;
    const bf16_t* Vd = VT + ((size_t)kvhead * (MT / 8) * 64 + q) * 8;
    (void)vrow0;
    const int cq = 32 * jj + q; const int r0 = min(max(rq - 4, 0), 56), c0 = min(max(cq - 8, 0), 48);
    const float* th = tab + (size_t)head * 15 * RPB_PITCH + RPB_SHIFT;
    const int cb = ML + b * CTXL, lb = b * SEQL;
    const int ko_lin = pi, ko_rem = (pi >> 3) * 64 + (pi & 7);
    const lds_u8* lk = limg + (pi >> 3) * 1024 + ((((pi & 7) * 16) + 128 * h) ^ (((pi >> 3) & 1) << 7));
    const lds_u8* lv = limg + 32768 + h * 1024 + q * 16;
#define TILE_INFO(t, tb, mode, aux) int tb, mode, aux; { const int t_ = (t); \
        if (t_ < 8) { tb = cb + 32 * t_; mode = 0; aux = 0; } \
        else if (type == 0) { const int i_ = t_ - 8; if (i_ < 8) { tb = lb + (r0 + i_) * 64 + 24 * jj; mode = 1; aux = i_; } else { tb = lb + (r0 + 4 * (i_ - 8)) * 64 + 24 * jj + 32; mode = 2; aux = i_ - 8; } } \
        else { const int m_ = m_lo + t_ - 8; tb = lb + t0 - 128 + 32 * m_; mode = m_ == 0 ? 3 : (m_ == 8 ? 4 : 0); aux = 0; } }
#define TILE_LOAD(L, t) do { TILE_INFO(t, tb_, md_, ax_); (void)ax_; if ((t) < 8) tile_load_lds(L, lk + 4096 * (t), lv + 4096 * (t)); else { const bool rem_ = md_ == 2; const int kt_ = tb_ + (rem_ ? ko_rem : ko_lin); const int g8_ = tb_ >> 3; \
        tile_load(L, Kh + (size_t)(kt_ >> 3) * 512 + (kt_ & 7) * 8, Vd + (size_t)(g8_ + (rem_ ? 8 * h : h)) * 512, Vd + (size_t)(g8_ + (rem_ ? 8 * (2 + h) : 2 + h)) * 512); } } while (0)
#define TILE_COMP(L, t, s_) do { TILE_INFO(t, tb_, md_, ax_); (void)tb_; \
        if (md_ == 0) tile_rest(a, s_, L, MBNone{negM}); \
        else if (md_ == 2) tile_rest(a, s_, L, MBGen<1>{th + (r0 + 4 * ax_ - rq + 7 + h) * RPB_PITCH + (47 - 8 * jj - q), c0 - 24 * jj - 32, 16u}); \
        else { MBGen<0> mb_; if (md_ == 1) { mb_.bl = th + (r0 + ax_ - rq + 7) * RPB_PITCH + (8 * h + 15 - 8 * jj - q); mb_.v0 = c0 - 24 * jj - 8 * h; mb_.width = 16u; } \
               else { mb_.bl = tab + 90 * RPB_PITCH; mb_.v0 = md_ == 3 ? q - 8 * h : q - 8 * h - 1000; mb_.width = md_ == 3 ? 0x7fffffffu : 1001u; } \
               tile_rest(a, s_, L, mb_); } } while (0)
#define ATT_STEP(LA, LC) { if (t >= nt) break; const f32x16 sq_ = tile_qk(qf, LA); if (!(probe & 1)) TILE_LOAD(LC, min(t + 2, nt - 1)); TILE_COMP(LA, t, sq_); ++t; }
    TileLd L0, L1, L2;
    TILE_LOAD(L0, 0); TILE_LOAD(L1, 1);
    int t = 0;
#pragma unroll 1
    for (;;) { ATT_STEP(L0, L2) ATT_STEP(L1, L0) ATT_STEP(L2, L1) }
#undef ATT_STEP
#undef TILE_COMP
#undef TILE_LOAD
#undef TILE_INFO
    const float lt = a.l + shx(a.l, 32, lane); const float inv = 1.0f / lt;
    bf16_t* yp = Y + (size_t)qrow * DM + ocol + 4 * h;
#pragma unroll
    for (int g = 0; g < 4; ++g) { u32x2 o0, o1;
        o0[0] = pk2(a.o0[4 * g] * inv, a.o0[4 * g + 1] * inv); o0[1] = pk2(a.o0[4 * g + 2] * inv, a.o0[4 * g + 3] * inv);
        o1[0] = pk2(a.o1[4 * g] * inv, a.o1[4 * g + 1] * inv); o1[1] = pk2(a.o1[4 * g + 2] * inv, a.o1[4 * g + 3] * inv);
        *(u32x2*)(yp + 8 * g) = o0; *(u32x2*)(yp + 32 + 8 * g) = o1; }
}
DI void sconv_item(int lane, int row0, const bf16_t* UBC, bf16_t* Y, const float* cw  ) {
    const int c = (lane & 31) * 8;
    f32x4 w[3][2];
#pragma unroll
    for (int k = 0; k < 3; ++k) { w[k][0] = *(const f32x4*)(cw + k * 256 + c); w[k][1] = *(const f32x4*)(cw + k * 256 + c + 4); }
#pragma unroll
    for (int it = 0; it < 4; ++it) {
        const int row = row0 + it * 2 + (lane >> 5);
        int t, L; if (row < ML) { t = row & (SEQL - 1); L = SEQL; } else { t = (row - ML) & (CTXL - 1); L = CTXL; }
        float acc[8];
#pragma unroll
        for (int j = 0; j < 8; ++j) acc[j] = 0.f;
#pragma unroll
        for (int k = 0; k < 3; ++k) {
            if ((k == 0 && t == 0) || (k == 2 && t == L - 1)) continue;
            const bf16_t* rp = UBC + (size_t)(row + k - 1) * UBCW + c; float u[8], cgv[8]; unpack8(*(const u32x4*)rp, u); unpack8(*(const u32x4*)(rp + 512), cgv);
#pragma unroll
            for (int j = 0; j < 8; ++j) acc[j] += (cgv[j] * u[j]) * w[k][j >> 2][j & 3];
        }
        float bg[8]; unpack8(*(const u32x4*)(UBC + (size_t)row * UBCW + 256 + c), bg);
        u32x4 o;
#pragma unroll
        for (int j = 0; j < 4; ++j) o[j] = pk2(bg[2 * j] * acc[2 * j], bg[2 * j + 1] * acc[2 * j + 1]);
        *(u32x4*)(Y + (size_t)row * DM + 768 + c) = o;
    }
}
template <int probe> DI void phase_mix(const Params& p, int wvs, int l, unsigned char* ldsraw) {
    float* tab = (float*)(ldsraw + LDS_TAB);
    const int tid = ltid(wvs); unsigned char* ws = p.ws;
    const float* rpb = p.in[I_RPB] + (size_t)l * 6 * 15 * 31; const float* shifts = (const float*)(ws + WS_SM) + l * 2;
    for (int i = tid; i < 91 * RPB_PITCH; i += 512) { const int ri = i / RPB_PITCH, dc = i % RPB_PITCH - RPB_SHIFT; tab[i] = (ri < 90 ? ((dc >= 0 && dc < 31) ? rpb[ri * 31 + dc] * LOG2E : 0.f) - shifts[0] : -shifts[1]); }
    __syncthreads();
    const bf16_t* QK = (const bf16_t*)(ws + WS_QK); const bf16_t* KB = (const bf16_t*)(ws + WS_KB); const bf16_t* VT = (const bf16_t*)(ws + WS_VT); const bf16_t* UBC = (const bf16_t*)(ws + WS_UBC); bf16_t* Y = (bf16_t*)(ws + (probe ? WS_PART : WS_Y));
    const float* sink = p.in[I_SINK] + l * 6; const float* cw = p.in[I_CONVC] + l * 3 * 256;
    const int wv = __builtin_amdgcn_readfirstlane(tid >> 6);
    const int b = blockIdx.x & 7, kb = blockIdx.x >> 3, nblk = ((int)gridDim.x - b + 7) >> 3;
    const int NAsz = l == 0 ? 136 : 128, WGsz = l == 0 ? 408 : 384, NAtot = 6 * NAsz, T = NAtot + 2 * WGsz;
    const int nNA = max(1, min(nblk - 1, (nblk * 17 + 16) / 32));
    const int I0 = kb < nNA ? kb * NAtot / nNA : NAtot + (kb - nNA) * (T - NAtot) / (nblk - nNA);
    const int I1 = kb < nNA ? (kb + 1) * NAtot / nNA : NAtot + (kb - nNA + 1) * (T - NAtot) / (nblk - nNA);
    const int sA = I0 < NAtot ? I0 / NAsz : 6 + (I0 - NAtot) / WGsz;
    lds_u8* img = (lds_u8*)(__attribute__((address_space(3))) unsigned char*)ldsraw;
    for (int si = 0; si < 2; ++si) { const int s = sA + si; if (s > 7) break;
        const size_t off = ((size_t)s * (MT / 8) + (ML + b * CTXL) / 8) * 512;
        const u32x4* ks = (const u32x4*)(KB + off); const u32x4* vs = (const u32x4*)(VT + off);
#pragma unroll
        for (int i = 0; i < 4; ++i) { const int pc = tid + 512 * i, grp = pc >> 6, j = pc & 63;
            *(__attribute__((address_space(3))) u32x4*)(img + si * 65536 + grp * 1024 + ((j * 16) ^ ((grp & 1) << 7))) = ks[pc];
            *(__attribute__((address_space(3))) u32x4*)(img + si * 65536 + 32768 + pc * 16) = vs[pc]; } }
    __syncthreads();
#pragma unroll 1
    for (int I = I0 + wv; I < I1; I += 8) {
        int type, idx, s;
        if (I < NAtot) { s = I / NAsz; const int w = I - s * NAsz;
            if (w < 128) { type = 0; idx = ((b * 64 + (w >> 1)) * 2 + (w & 1)) * 6 + s; } else { type = 2; idx = (b * 8 + (w - 128)) * 6 + s; } }
        else { const int J = I - NAtot, kv = J / WGsz, w = J - kv * WGsz; s = 6 + kv;
            if (w < 384) { type = 1; idx = (b * 128 + w / 3) * 6 + kv * 3 + w % 3; } else { const int w2 = w - 384; type = 3; idx = (b * 8 + w2 / 3) * 6 + kv * 3 + w2 % 3; } }
        attn_item<probe>(tid & 63, type, idx, QK, KB, VT, Y, tab, sink, shifts, img + (s - sA) * 65536);
    }
    if (!(probe & 4)) { const int lw = kb * 8 + wv, nlw = nblk * 8, n_sc = l == 0 ? 544 : 512;
#pragma unroll 1
      for (int k = lw; k < n_sc; k += nlw) sconv_item(tid & 63, k < 512 ? b * SEQL + 8 * k : ML + b * CTXL + 8 * (k - 512), UBC, Y, cw); }
}


constexpr int NPH = 17;
#ifndef MK_MULTI
#define MK_MULTI 0
#endif
#define GLOBAL_AS __attribute__((address_space(1)))
__global__ void __launch_bounds__(512, 2) mega_fwd(Params p_in) {
    Params p = p_in;
#pragma unroll
    for (int i = 0; i < 20; ++i) p.in[i] = (const float*)(GLOBAL_AS const float*)p_in.in[i];
    p.out = (float*)(GLOBAL_AS float*)p_in.out; p.ws = (unsigned char*)(GLOBAL_AS unsigned char*)p_in.ws;
    extern __shared__ __attribute__((aligned(16))) unsigned char lds[];
    cg::grid_group grid = cg::this_grid();
    const int G = gridDim.x, bx = blockIdx.x;
    const int wvs = __builtin_amdgcn_readfirstlane(threadIdx.x >> 6);
    PG8_LAS unsigned char* ldsl = (PG8_LAS unsigned char*)lds;
    volatile LAS unsigned* xst = (volatile LAS unsigned*)(ldsl + LDS_STAGE);
    if (threadIdx.x < 4) xst[threadIdx.x] = 0u;
    __syncthreads();
    XcdBarrier xbar; xbar.bar = (unsigned*)(p.ws + WS_BAR); xbar.x = 0; xbar.st = xst;
    if (p.ph_hi - p.ph_lo > 1) xbar = xcd_barrier_post((unsigned*)(p.ws + WS_BAR), xst);
#ifndef DUP_MASK
#define DUP_MASK 0
#endif
#define MIX_PROBE 2
#define DUP(c) for (int rep_ = 0; rep_ < (((DUP_MASK) >> (c)) & 1) + 1; ++rep_)
#define RUN(k) ((k) >= p.ph_lo && (k) < p.ph_hi)
#define SEAM(k) do { if ((k) + 1 < p.ph_hi) { if ((k) == 0 && p.ph_lo < 0) grid.sync(); xcd_barrier(xbar, ltid(wvs) == 0);     if ((DUP_MASK >> 8) & 1) xcd_barrier(xbar, ltid(wvs) == 0); } } while (0)
#define LAUNDER(ws, l) unsigned long long ws##_u = (unsigned long long)p.ws; int l = l0; asm volatile("" : "+s"(ws##_u), "+s"(l)); unsigned char* ws = (unsigned char*)(GLOBAL_AS unsigned char*)ws##_u
    if (RUN(0)) { DUP(0) { phase_prep(p, wvs, (float*)lds); __syncthreads(); } SEAM(0); }
#pragma unroll 1
    for (int l0 = 0; l0 < 2; ++l0) {
        const int pb = 1 + 8 * l0;
        if (RUN(pb + 0)) { LAUNDER(ws, l); DUP(1)
            phase_prenorm(wvs, p.in[I_X], l == 0 ? (const bf16_t*)nullptr : (const bf16_t*)(ws + WS_RB), p.in[I_CTX], l == 0 ? (const bf16_t*)nullptr : (const bf16_t*)(ws + WS_RB) + (size_t)ML * DM, p.in[I_GATTN] + l * DM, (const float*)(ws + WS_MOD) + (size_t)l * 9 * MODW, 0, DM, (bf16_t*)p.out, MT, (const bf16_t*)(ws + WS_PART), l == 0 ? 0 : 11, nullptr, l == 0 ? (bf16_t*)(ws + WS_RB) : (bf16_t*)nullptr);
            if (l == 0) { __syncthreads(); transpose_tiles(p, wvs, (float*)lds, 0, 3008, bx, G); }
            SEAM(pb + 0); }
        if (RUN(pb + 1)) { LAUNDER(ws, l);
            const bf16_t* H = (const bf16_t*)p.out; const bf16_t* WinT = (const bf16_t*)(ws + WS_WIN + l * SZ_WIN);
            PG8_LAS float* ropel = (PG8_LAS float*)(ldsl + LDS_TAB);
            { const int tid_ = ltid(wvs); const f32x4* rsrc = (const f32x4*)(ws + WS_ROPE); ((PG8_LAS f32x4*)ropel)[tid_] = rsrc[tid_]; }
            __syncthreads();
            DUP(2) {
              pg8::Gemm g{H, WinT, MT, 2048, DM, wvs}; pg8::TwoSegOrder S; S.init(MT, 2048, DM / 64, WinT + (size_t)2048 * DM, H, VTR, MT, 1, DM / 64, G, bx);
              pg8::EpiInProj E{(bf16_t*)(ws + WS_QK), (bf16_t*)(ws + WS_KB), (bf16_t*)(ws + WS_UBC), (bf16_t*)(ws + WS_VT), (const float*)(ws + WS_NG) + l * 256, ropel, ropel + 1024};
              pg8::gemm_phase<pg8::EpiInProj, pg8::TwoSegOrder, false>(ldsl, g, S, E, nullptr);
            }
            if (l == 0) { const int rem = (136 * 8 + 2 * 136) % G;
              if (rem == 0) transpose_tiles(p, wvs, (float*)lds, 3008, 6016, bx, G); else if (bx >= rem) transpose_tiles(p, wvs, (float*)lds, 3008, 6016, bx - rem, G - rem); }
            SEAM(pb + 1);
        }
        if (RUN(pb + 2)) { phase_mix<0>(p, wvs, l0, lds); __syncthreads();
            if ((DUP_MASK >> 3) & 1) { phase_mix<MIX_PROBE>(p, wvs, l0, lds); __syncthreads(); } SEAM(pb + 2); }
        if (RUN(pb + 3)) { LAUNDER(ws, l);
            const bf16_t* Yp = (const bf16_t*)(ws + WS_Y); const bf16_t* WoT = (const bf16_t*)(ws + WS_WO + l * SZ_WO);
            pg8::Gemm g{Yp, WoT, ML, DM, DM, wvs}; pg8::TwoSegOrder S; S.init(ML, DM, DM / 64, Yp + (size_t)ML * DM, WoT, l == 0 ? MC : 0, DM, 4, 4, G, bx);
            pg8::EpiResid E{(const void*)(ws + WS_RB), (void*)(ws + WS_RB), 1, 1, (bf16_t*)(ws + WS_PART), (const float*)(ws + WS_MOD) + (size_t)l * 9 * MODW + 2 * DM};
            pg8::gemm_phase<pg8::EpiResid, pg8::TwoSegOrder, false>(ldsl, g, S, E, nullptr);
            SEAM(pb + 3);
        }
        if (RUN(pb + 4)) { LAUNDER(ws, l); DUP(1)
            phase_prenorm(wvs, nullptr, (const bf16_t*)(ws + WS_RB), p.in[I_CTX], nullptr, p.in[I_GFFN] + l * DM, (const float*)(ws + WS_MOD) + (size_t)l * 9 * MODW, 3 * DM, 4 * DM, (bf16_t*)p.out, l == 0 ? MT : ML, (const bf16_t*)(ws + WS_PART), 4, (bf16_t*)(ws + WS_RB) + (size_t)ML * DM, nullptr); SEAM(pb + 4); }
        if (RUN(pb + 5)) { LAUNDER(ws, l);
            const int M = l == 0 ? MT : ML;
            pg8::Gemm g{(const bf16_t*)p.out, (const bf16_t*)(ws + WS_WUP + l * SZ_WUP), M, UPW, DM, wvs}; pg8::StaticOrder S; S.init(M, UPW, G, bx); S.ntk = DM / 64;
            pg8::EpiUpConv E{(bf16_t*)(ws + WS_ACT), (bf16_t*)(ws + WS_UPB), p.in[I_CONVF] + (size_t)l * 3 * UPW};
            DUP(5) pg8::gemm_phase<pg8::EpiUpConv, pg8::StaticOrder, false>(ldsl, g, S, E, nullptr);
            SEAM(pb + 5);
        }
        if (RUN(pb + 6)) { LAUNDER(ws, l); DUP(6) phase_fixup(wvs, (const bf16_t*)(ws + WS_UPB), (bf16_t*)(ws + WS_ACT), p.in[I_CONVF] + (size_t)l * 3 * UPW, l == 0 ? MT : ML); SEAM(pb + 6); }
        if (RUN(pb + 7)) { LAUNDER(ws, l);
            const bf16_t* ACTp = (const bf16_t*)(ws + WS_ACT); const bf16_t* WdT = (const bf16_t*)(ws + WS_WD + l * SZ_WD);
            pg8::Gemm g{ACTp, WdT, ML, DM, DFF, wvs}; pg8::TwoSegOrder S; S.init(ML, DM, DFF / 64, ACTp + (size_t)ML * DFF, WdT, l == 0 ? MC : 0, DM, 11, 4, G, bx);
            pg8::EpiResid E{(const void*)(ws + WS_RB), l == 0 ? (void*)(ws + WS_RB) : (void*)p.out, 1, l == 0 ? 1 : 0, (bf16_t*)(ws + WS_PART), (const float*)(ws + WS_MOD) + (size_t)l * 9 * MODW + 5 * DM};
            pg8::gemm_phase<pg8::EpiResid, pg8::TwoSegOrder, false>(ldsl, g, S, E, nullptr);
            SEAM(pb + 7);
        }
    }
}

extern "C" void kernel_launch(void* const* d_in, const int* in_sizes, int n_in, void* d_out, int out_size, void* d_ws, size_t ws_size, hipStream_t stream) {
    static int grid = 0;
    if (grid == 0) {
        if (n_in != 20 || out_size != ML * DM || ws_size < WS_END) { fprintf(stderr, "kernel_launch: unexpected shapes (n_in %d out %d ws %zu need %zu)\n", n_in, out_size, ws_size, (size_t)WS_END); grid = -1; return; }
        int dev = 0, cus = 0, per_cu = 0;
        (void)hipGetDevice(&dev); (void)hipDeviceGetAttribute(&cus, hipDeviceAttributeMultiprocessorCount, dev);
        if (hipFuncSetAttribute((const void*)mega_fwd, hipFuncAttributeMaxDynamicSharedMemorySize, LDS_BYTES) != hipSuccess) { fprintf(stderr, "kernel_launch: hipFuncSetAttribute failed\n"); grid = -1; return; }
        if (hipOccupancyMaxActiveBlocksPerMultiprocessor(&per_cu, (const void*)mega_fwd, 512, LDS_BYTES) != hipSuccess || per_cu < 1) { fprintf(stderr, "kernel_launch: occupancy query failed (%d)\n", per_cu); (void)hipGetLastError(); per_cu = 1; }
        grid = cus * per_cu;
        fprintf(stderr, "kernel_launch: grid %d (cus %d x %d)\n", grid, cus, per_cu);
        if (grid < 128 || (grid & 7)) { fprintf(stderr, "kernel_launch: the mixer phase's LDS context images need a grid of >= 128 workgroups, a multiple of 8 (got %d)\n", grid); grid = -1; return; }
    }
    if (grid < 0) return;
    if (hipMemsetAsync((char*)d_ws + WS_BAR, 0, WS_BAR_BYTES, stream) != hipSuccess) { fprintf(stderr, "kernel_launch: memset failed\n"); return; }
    Params p{};
    for (int i = 0; i < 20; ++i) p.in[i] = (const float*)d_in[i];
    p.out = (float*)d_out; p.ws = (unsigned char*)d_ws;
#if MK_MULTI
    for (int k = 0; k < NPH; ++k) { p.ph_lo = k; p.ph_hi = k + 1; hipLaunchKernelGGL(mega_fwd, dim3(grid), dim3(512), LDS_BYTES, stream, p); }
#else
    p.ph_lo = 0; p.ph_hi = NPH;
    void* args[] = {&p};
    hipError_t e = hipLaunchCooperativeKernel((const void*)mega_fwd, dim3(grid), dim3(512), args, LDS_BYTES, stream);
    if (e != hipSuccess) fprintf(stderr, "kernel_launch: cooperative launch failed: %s (grid %d)\n", hipGetErrorString(e), grid);
#endif
}
```
